# Optimizing an MI355X kernel written in HIP

```python
import jax, jax.numpy as jnp
from jax import lax
import numpy as np

D_MODEL = 2048
BATCH = 16
SEQ = 2048
DEPTH = 2

N_EVEN = (DEPTH + 1) // 2
N_ODD = DEPTH // 2
D_FF = 5632
EPS = 1e-6
V_HEAD = 128
MLA_HEADS = (D_MODEL // 2) // V_HEAD
QK_NOPE = 128
QK_ROPE = 64
Q_LORA = 512
KV_LORA = 512
ROPE_THETA = 10000.0
Q_BLOCK = 128
CONV_CH = D_MODEL - MLA_HEADS * V_HEAD
CONV_GROUPS = 8
CONV_WIDTH = 31
GM_WIDTH = D_MODEL
GM_GROUPS = 8
CHUNK = 128
OFF_KV = Q_LORA
OFF_KR = Q_LORA + KV_LORA
OFF_CONV = Q_LORA + KV_LORA + QK_ROPE
IN_EVEN = OFF_CONV + 2 * CONV_CH

kernel_name = "hybrid_mla_conv_gmlp_macaron"


def rmsnorm(x, g):
    xf = x.astype(jnp.float32)
    y = xf * lax.rsqrt(jnp.mean(xf * xf, axis=-1, keepdims=True) + EPS)
    return (y * g.astype(jnp.float32)).astype(x.dtype)


def layernorm(x, g, b):
    xf = x.astype(jnp.float32)
    mu = jnp.mean(xf, axis=-1, keepdims=True)
    var = jnp.mean(jnp.square(xf - mu), axis=-1, keepdims=True)
    y = (xf - mu) * lax.rsqrt(var + EPS)
    return (y * g.astype(jnp.float32) + b.astype(jnp.float32)).astype(x.dtype)


def swiglu(x, w_gate, w_up, w_down):
    return (jax.nn.silu(x @ w_gate) * (x @ w_up)) @ w_down


def apply_rope(x, cos, sin):
    half = x.shape[-1] // 2
    x1, x2 = x[..., :half], x[..., half:]
    return jnp.concatenate([x1 * cos - x2 * sin, x2 * cos + x1 * sin], axis=-1)


def mla_attention(c_q, c_kv, k_rope, cos, sin, q_norm_g, kv_norm_g, w_uq, w_ukv):
    B, S, _ = c_q.shape
    q = (rmsnorm(c_q, q_norm_g) @ w_uq).reshape(B, S, MLA_HEADS, QK_NOPE + QK_ROPE)
    q_nope = q[..., :QK_NOPE]
    q_pe = apply_rope(q[..., QK_NOPE:], cos[:, :, None, :], sin[:, :, None, :])
    kv = (rmsnorm(c_kv, kv_norm_g) @ w_ukv).reshape(B, S, MLA_HEADS, QK_NOPE + V_HEAD)
    k_nope, v = kv[..., :QK_NOPE], kv[..., QK_NOPE:]
    k_pe = apply_rope(k_rope, cos, sin)
    scale = (QK_NOPE + QK_ROPE) ** -0.5
    n_blk = S // Q_BLOCK
    qn_b = q_nope.reshape(B, n_blk, Q_BLOCK, MLA_HEADS, QK_NOPE).transpose(1, 0, 2, 3, 4)
    qp_b = q_pe.reshape(B, n_blk, Q_BLOCK, MLA_HEADS, QK_ROPE).transpose(1, 0, 2, 3, 4)
    key_idx = jnp.arange(S)

    def block(args):
        qn, qp, i = args
        s = (jnp.einsum('bqhd,bkhd->bhqk', qn, k_nope)
             + jnp.einsum('bqhr,bkr->bhqk', qp, k_pe)).astype(jnp.float32) * scale
        q_idx = i * Q_BLOCK + jnp.arange(Q_BLOCK)
        s = jnp.where(key_idx[None, :] <= q_idx[:, None], s, -jnp.inf)
        p = jax.nn.softmax(s, axis=-1).astype(v.dtype)
        return jnp.einsum('bhqk,bkhd->bqhd', p, v)

    o = lax.map(block, (qn_b, qp_b, jnp.arange(n_blk)))
    return o.transpose(1, 0, 2, 3, 4).reshape(B, S, MLA_HEADS * V_HEAD)


def conformer_conv(h, conv_w, conv_b, norm_g, norm_b):
    B, S, _ = h.shape
    a, gate = h[..., :CONV_CH], h[..., CONV_CH:]
    z = a * jax.nn.sigmoid(gate)
    z = lax.conv_general_dilated(z, conv_w[:, None, :], window_strides=(1,),
                                 padding=[(CONV_WIDTH - 1, 0)],
                                 dimension_numbers=('NWC', 'WIO', 'NWC'),
                                 feature_group_count=CONV_CH) + conv_b
    gsz = CONV_CH // CONV_GROUPS
    z = layernorm(z.reshape(B, S, CONV_GROUPS, gsz),
                  norm_g.reshape(CONV_GROUPS, gsz), norm_b.reshape(CONV_GROUPS, gsz))
    return jax.nn.silu(z).reshape(B, S, CONV_CH)


def chunked_sgu(h, v_norm_g, v_norm_b, w_s, b_s):
    B, S, _ = h.shape
    z = jax.nn.gelu(h)
    u, v = z[..., :GM_WIDTH], z[..., GM_WIDTH:]
    v = layernorm(v, v_norm_g, v_norm_b)
    v = v.reshape(B, S // CHUNK, CHUNK, GM_GROUPS, GM_WIDTH // GM_GROUPS)
    w = w_s * jnp.tril(jnp.ones((CHUNK, CHUNK), w_s.dtype))[None]
    s = jnp.einsum('gts,bcsgd->bctgd', w, v) + b_s.T[None, None, :, :, None]
    return u * s.reshape(B, S, GM_WIDTH)


def setup_inputs(seed: int = 0) -> dict:
    key = jax.random.key(seed)
    ks = iter(jax.random.split(key, 48))
    f32 = jnp.float32

    def w(shape, fan_in):
        return jax.random.normal(next(ks), shape, f32) * fan_in ** -0.5

    def gain(shape):
        return 1.0 + 0.02 * jax.random.normal(next(ks), shape, f32)

    def small(shape):
        return 0.02 * jax.random.normal(next(ks), shape, f32)

    x = jax.random.normal(next(ks), (BATCH, SEQ, D_MODEL), f32)
    offs = jax.random.randint(next(ks), (BATCH, 1), 0, 4096, dtype=jnp.int32)
    positions = (offs + jnp.arange(SEQ, dtype=jnp.int32)[None, :]).astype(jnp.int32)
    return {
        "x": x,
        "positions": positions,
        "ffn_a_pre_g": gain((DEPTH, D_MODEL)),
        "ffn_a_post_g": gain((DEPTH, D_MODEL)),
        "ffn_a_w_gate": w((DEPTH, D_MODEL, D_FF), D_MODEL),
        "ffn_a_w_up": w((DEPTH, D_MODEL, D_FF), D_MODEL),
        "ffn_a_w_down": w((DEPTH, D_FF, D_MODEL), D_FF),
        "ffn_b_pre_g": gain((DEPTH, D_MODEL)),
        "ffn_b_post_g": gain((DEPTH, D_MODEL)),
        "ffn_b_w_gate": w((DEPTH, D_MODEL, D_FF), D_MODEL),
        "ffn_b_w_up": w((DEPTH, D_MODEL, D_FF), D_MODEL),
        "ffn_b_w_down": w((DEPTH, D_FF, D_MODEL), D_FF),
        "even_pre_g": gain((N_EVEN, D_MODEL)),
        "even_post_g": gain((N_EVEN, D_MODEL)),
        "even_w_in": w((N_EVEN, D_MODEL, IN_EVEN), D_MODEL),
        "even_q_norm_g": gain((N_EVEN, Q_LORA)),
        "even_kv_norm_g": gain((N_EVEN, KV_LORA)),
        "even_w_uq": w((N_EVEN, Q_LORA, MLA_HEADS * (QK_NOPE + QK_ROPE)), Q_LORA),
        "even_w_ukv": w((N_EVEN, KV_LORA, MLA_HEADS * (QK_NOPE + V_HEAD)), KV_LORA),
        "even_conv_w": w((N_EVEN, CONV_WIDTH, CONV_CH), CONV_WIDTH),
        "even_conv_b": small((N_EVEN, CONV_CH)),
        "even_conv_norm_g": gain((N_EVEN, CONV_CH)),
        "even_conv_norm_b": small((N_EVEN, CONV_CH)),
        "even_w_out": w((N_EVEN, D_MODEL, D_MODEL), D_MODEL),
        "odd_pre_g": gain((N_ODD, D_MODEL)),
        "odd_post_g": gain((N_ODD, D_MODEL)),
        "odd_w_in": w((N_ODD, D_MODEL, 2 * GM_WIDTH), D_MODEL),
        "odd_v_norm_g": gain((N_ODD, GM_WIDTH)),
        "odd_v_norm_b": small((N_ODD, GM_WIDTH)),
        "odd_w_s": w((N_ODD, GM_GROUPS, CHUNK, CHUNK), CHUNK),
        "odd_b_s": gain((N_ODD, GM_GROUPS, CHUNK)),
        "odd_w_out": w((N_ODD, GM_WIDTH, D_MODEL), GM_WIDTH),
    }


def reference(x, positions,
              ffn_a_pre_g, ffn_a_post_g, ffn_a_w_gate, ffn_a_w_up, ffn_a_w_down,
              ffn_b_pre_g, ffn_b_post_g, ffn_b_w_gate, ffn_b_w_up, ffn_b_w_down,
              even_pre_g, even_post_g, even_w_in, even_q_norm_g, even_kv_norm_g,
              even_w_uq, even_w_ukv, even_conv_w, even_conv_b, even_conv_norm_g,
              even_conv_norm_b, even_w_out,
              odd_pre_g, odd_post_g, odd_w_in, odd_v_norm_g, odd_v_norm_b,
              odd_w_s, odd_b_s, odd_w_out):
    inv_freq = ROPE_THETA ** (-jnp.arange(0, QK_ROPE, 2, dtype=jnp.float32) / QK_ROPE)
    ang = positions.astype(jnp.float32)[..., None] * inv_freq
    cos, sin = jnp.cos(ang).astype(x.dtype), jnp.sin(ang).astype(x.dtype)

    for l in range(DEPTH):
        h = rmsnorm(x, ffn_a_pre_g[l])
        x = x + 0.5 * rmsnorm(swiglu(h, ffn_a_w_gate[l], ffn_a_w_up[l], ffn_a_w_down[l]), ffn_a_post_g[l])
        if l % 2 == 0:
            i = l // 2
            h = rmsnorm(x, even_pre_g[i])
            p = h @ even_w_in[i]
            a = mla_attention(p[..., :OFF_KV], p[..., OFF_KV:OFF_KR], p[..., OFF_KR:OFF_CONV],
                              cos, sin, even_q_norm_g[i], even_kv_norm_g[i],
                              even_w_uq[i], even_w_ukv[i])
            c = conformer_conv(p[..., OFF_CONV:], even_conv_w[i], even_conv_b[i],
                               even_conv_norm_g[i], even_conv_norm_b[i])
            y = jnp.concatenate([a, c], axis=-1) @ even_w_out[i]
            x = x + rmsnorm(y, even_post_g[i])
        else:
            i = l // 2
            h = rmsnorm(x, odd_pre_g[i])
            y = chunked_sgu(h @ odd_w_in[i], odd_v_norm_g[i], odd_v_norm_b[i],
                            odd_w_s[i], odd_b_s[i]) @ odd_w_out[i]
            x = x + rmsnorm(y, odd_post_g[i])
        h = rmsnorm(x, ffn_b_pre_g[l])
        x = x + 0.5 * rmsnorm(swiglu(h, ffn_b_w_gate[l], ffn_b_w_up[l], ffn_b_w_down[l]), ffn_b_post_g[l])
    return x
```

```cpp
#include <hip/hip_runtime.h>
#include <hip/hip_cooperative_groups.h>
#include <cstdio>
#include <cstdint>
#include <cmath>
#include <cstddef>
namespace cg = cooperative_groups;

#ifndef REPEAT_MASK
#define REPEAT_MASK 0
#endif
#ifndef BAR_TRIPLE
#define BAR_TRIPLE 0
#endif
#ifndef NORM_DUMMY
#define NORM_DUMMY 0
#endif
#ifndef PG8_SP2
#define PG8_SP2 1
#endif
#ifndef MK_DEBUG_MULTI
#define MK_DEBUG_MULTI 0
#endif

#define LAS __attribute__((address_space(3)))
typedef unsigned short bf16_t;
typedef short bf16x8 __attribute__((ext_vector_type(8)));
typedef float f32x4 __attribute__((ext_vector_type(4)));
typedef float f32x2 __attribute__((ext_vector_type(2)));
typedef unsigned u32x4 __attribute__((ext_vector_type(4)));
typedef unsigned u32x2 __attribute__((ext_vector_type(2)));

constexpr int M = 32768, D = 2048, FF = 5632, SEQ = 2048, NBATCH = 16;
constexpr int P_LD = 3328;
constexpr int OFF_CKV = 512, OFF_KR = 1024, OFF_CONV = 1088, OFF_GATE = 2112, OFF_KPE = 3136;
constexpr int QW = 1536;
constexpr float EPS = 1e-6f;
constexpr int NPHASE = 23;

constexpr size_t MiB = 1u << 20;
constexpr size_t WS_WGU = 1 * MiB;
constexpr size_t WS_WD = 177 * MiB;
constexpr size_t WS_WIN_E = 265 * MiB;
constexpr size_t WS_WUQ = 278 * MiB;
constexpr size_t WS_WUKV = 280 * MiB;
constexpr size_t WS_WOUT_E = 282 * MiB;
constexpr size_t WS_WIN_O = 290 * MiB;
constexpr size_t WS_WOUT_O = 306 * MiB;
constexpr size_t WS_CS = 314 * MiB;
constexpr size_t WS_H = 322 * MiB;
constexpr size_t WS_Y = 450 * MiB;
constexpr size_t WS_ACT = 578 * MiB;
constexpr size_t WS_END = 930 * MiB;
constexpr int LDS_BYTES = 147456;

__device__ __forceinline__ unsigned cvt_pk_bf16(float lo, float hi) { unsigned r; asm("v_cvt_pk_bf16_f32 %0, %1, %2" : "=v"(r) : "v"(lo), "v"(hi)); return r; }
__device__ __forceinline__ float bf_lo(unsigned u) { return __uint_as_float(u << 16); }
__device__ __forceinline__ float bf_hi(unsigned u) { return __uint_as_float(u & 0xffff0000u); }
__device__ __forceinline__ float wave_sum(float v) {
#pragma unroll
    for (int o = 1; o < 64; o <<= 1) v += __shfl_xor(v, o);
    return v;
}
__device__ __forceinline__ float fast_sigmoid(float x) { return __builtin_amdgcn_rcpf(1.0f + __builtin_amdgcn_exp2f(-1.4426950408889634f * x)); }
__device__ __forceinline__ float silu_f(float x) { return x * fast_sigmoid(x); }
__device__ __forceinline__ float gelu_tanh_f(float x) {
    const float y = 1.5957691216057308f * (x + 0.044715f * x * x * x);
    return x * fast_sigmoid(y);
}
#define LDS_WAIT() asm volatile("s_waitcnt lgkmcnt(0)" ::: "memory")

namespace pg8 {
constexpr int BM = 256, BK = 64, HALF = 128, HTB = HALF * BK * 2, STAGE_BYTES = 8 * HTB, NXCD = 8, WGM = 8;
__device__ __forceinline__ int lds_byte(int r, int c) { const int st = (r >> 4) * 2 + (c >> 5), rr = r & 15, cc = c & 31, ob = rr * 64 + cc * 2; return st * 1024 + (ob ^ (((ob >> 9) & 1) << 5)); }
__device__ __forceinline__ void stage_rc(int b, int& R, int& C) { const int st = b / 1024, sb = b % 1024, swz = sb ^ (((sb >> 9) & 1) << 5); R = (st >> 1) * 16 + swz / 64; C = (st & 1) * 32 + (swz % 64) / 2; }
__device__ __forceinline__ int perm32(int rho) { const int n = rho >> 4, i = rho & 15; return 8 * (i >> 2) + 4 * n + (i & 3); }

struct Unit { int pm, pn; };
struct Gemm { const bf16_t* A; const bf16_t* Bt; int M, N, K, lda, ldb; };

struct StaticOrder {
    int nM, nN, nwg, G, c;
    __device__ void init(int M_, int N_, int G_, int c_) { nM = M_ / BM; nN = N_ / BM; nwg = nM * nN; G = G_; c = c_; }
    __device__ bool next(int i, Unit& u) const {
        const long L = (long)i * G + c; if (L >= nwg) return false;
        int wgid = (int)L; { const int q = nwg / NXCD, r = nwg % NXCD, xcd = wgid % NXCD, off = wgid / NXCD; wgid = (xcd < r ? xcd * (q + 1) : r * (q + 1) + (xcd - r) * q) + off; }
        const int nig = WGM * nN, gid = wgid / nig, fm = gid * WGM, gsz = (nM - fm) < WGM ? (nM - fm) : WGM;
        u.pm = fm + ((wgid % nig) % gsz); u.pn = (wgid % nig) / gsz; return true;
    }
};


struct EpiSwiGLU {
    bf16_t* O; int ldc;
    __device__ __forceinline__ void operator()(const f32x4 (&acc)[2][2][4][2], const Unit& u, int wr, int wc, int fr, int fq) const {
        const int row0 = u.pm * BM + wr * 64 + fr, col0 = u.pn * HALF + wc * 32 + 8 * fq;
#pragma unroll
        for (int ai = 0; ai < 2; ++ai)
#pragma unroll
            for (int m = 0; m < 4; ++m) {
                bf16_t* rowp = O + (size_t)(row0 + ai * HALF + m * 16) * ldc + col0;
                f32x4 v0, v1;
#pragma unroll
                for (int n = 0; n < 2; ++n)
#pragma unroll
                    for (int q = 0; q < 2; ++q) {
                        const f32x2 gg = {acc[ai][0][m][n][2 * q], acc[ai][0][m][n][2 * q + 1]}, uu = {acc[ai][1][m][n][2 * q], acc[ai][1][m][n][2 * q + 1]};
                        const f32x2 t = gg * (-1.4426950408889634f);
                        f32x2 e; e.x = __builtin_amdgcn_exp2f(t.x); e.y = __builtin_amdgcn_exp2f(t.y);
                        const f32x2 d = e + 1.0f;
                        f32x2 r; r.x = __builtin_amdgcn_rcpf(d.x); r.y = __builtin_amdgcn_rcpf(d.y);
                        const f32x2 o = (gg * uu) * r;
                        if (n == 0) { v0[2 * q] = o.x; v0[2 * q + 1] = o.y; } else { v1[2 * q] = o.x; v1[2 * q + 1] = o.y; }
                    }
                u32x4 w; w.x = cvt_pk_bf16(v0[0], v0[1]); w.y = cvt_pk_bf16(v0[2], v0[3]); w.z = cvt_pk_bf16(v1[0], v1[1]); w.w = cvt_pk_bf16(v1[2], v1[3]);
                *(u32x4*)rowp = w;
            }
    }
};
template <int ACT  > struct EpiBf16 {
    bf16_t* O; int ldc;
    __device__ __forceinline__ void operator()(const f32x4 (&acc)[2][2][4][2], const Unit& u, int wr, int wc, int fr, int fq) const {
        const int row0 = u.pm * BM + wr * 64 + fr, col0 = u.pn * BM + wc * 32 + 8 * fq;
#pragma unroll
        for (int ai = 0; ai < 2; ++ai)
#pragma unroll
            for (int m = 0; m < 4; ++m) {
                bf16_t* rowp = O + (size_t)(row0 + ai * HALF + m * 16) * ldc + col0;
#pragma unroll
                for (int bj = 0; bj < 2; ++bj) {
                    f32x4 v0 = acc[ai][bj][m][0], v1 = acc[ai][bj][m][1];
                    if (ACT == 1) {
#pragma unroll
                        for (int j = 0; j < 4; ++j) { v0[j] = gelu_tanh_f(v0[j]); v1[j] = gelu_tanh_f(v1[j]); }
                    }
                    u32x4 w; w.x = cvt_pk_bf16(v0[0], v0[1]); w.y = cvt_pk_bf16(v0[2], v0[3]); w.z = cvt_pk_bf16(v1[0], v1[1]); w.w = cvt_pk_bf16(v1[2], v1[3]);
                    *(u32x4*)(rowp + bj * HALF) = w;
                }
            }
    }
};
struct EpiQRope {
    bf16_t* O; const float* cs; float qscale;
    __device__ __forceinline__ void operator()(const f32x4 (&acc)[2][2][4][2], const Unit& u, int wr, int wc, int fr, int fq) const {
        const int row0 = u.pm * BM + wr * 64 + fr, col0 = u.pn * BM + wc * 32 + 8 * fq;
#pragma unroll
        for (int ai = 0; ai < 2; ++ai)
#pragma unroll
            for (int m = 0; m < 4; ++m) {
                const int row = row0 + ai * HALF + m * 16;
                bf16_t* rowp = O + (size_t)row * QW + col0;
#pragma unroll
                for (int bj = 0; bj < 2; ++bj) {
                    f32x4 v0 = acc[ai][bj][m][0], v1 = acc[ai][bj][m][1];
                    const int cc = (col0 + bj * HALF) % 192;
                    if (cc >= 128) {
                        const int i0 = (cc - 128) >> 1;
                        const f32x4 c01 = *(const f32x4*)(cs + (size_t)row * 64 + i0 * 2), c23 = *(const f32x4*)(cs + (size_t)row * 64 + i0 * 2 + 4);
                        f32x4 r0, r1;
                        r0[0] = v0[0] * c01[0] - v0[1] * c01[1]; r0[1] = v0[1] * c01[0] + v0[0] * c01[1];
                        r0[2] = v0[2] * c01[2] - v0[3] * c01[3]; r0[3] = v0[3] * c01[2] + v0[2] * c01[3];
                        r1[0] = v1[0] * c23[0] - v1[1] * c23[1]; r1[1] = v1[1] * c23[0] + v1[0] * c23[1];
                        r1[2] = v1[2] * c23[2] - v1[3] * c23[3]; r1[3] = v1[3] * c23[2] + v1[2] * c23[3];
                        v0 = r0; v1 = r1;
                    }
                    v0 = v0 * qscale; v1 = v1 * qscale;
                    u32x4 w; w.x = cvt_pk_bf16(v0[0], v0[1]); w.y = cvt_pk_bf16(v0[2], v0[3]); w.z = cvt_pk_bf16(v1[0], v1[1]); w.w = cvt_pk_bf16(v1[2], v1[3]);
                    *(u32x4*)(rowp + bj * HALF) = w;
                }
                asm volatile("" ::: "memory");
            }
    }
};

struct EpiAny {
    int kind;
    bf16_t* O; int ldc; const float* cs; float qscale;
    __device__ __forceinline__ void operator()(const f32x4 (&acc)[2][2][4][2], const Unit& u, int wr, int wc, int fr, int fq) const {
        if (kind == 0) { EpiSwiGLU e{O, ldc}; e(acc, u, wr, wc, fr, fq); }
        else if (kind == 1) { EpiBf16<0> e{O, ldc}; e(acc, u, wr, wc, fr, fq); }
        else if (kind == 2) { EpiBf16<1> e{O, ldc}; e(acc, u, wr, wc, fr, fq); }
        else { EpiQRope e{O, cs, qscale}; e(acc, u, wr, wc, fr, fq); }
    }
};

template <class Epi>
__device__ __forceinline__ void gemm_phase(LAS unsigned char* lds, const Gemm g, const StaticOrder& S, const Epi& E, const int tid) {
    const int wid = __builtin_amdgcn_readfirstlane(tid >> 6), lane = tid & 63, wr = wid >> 2, wc = wid & 3, fr = lane & 15, fq = lane >> 4;
    const int K = g.K, nt = K / BK;
    unsigned voffA[2], voffB[2];
#pragma unroll
    for (int i = 0; i < 2; ++i) { int R, C; stage_rc(tid * 16 + i * 8192, R, C); const int Rb = (R & ~31) + perm32(R & 31);
        voffA[i] = (unsigned)(R * g.lda + C) * 2u; voffB[i] = (unsigned)(Rb * g.ldb + C) * 2u; }
    const size_t kstep = (size_t)(BK * 2);
    const size_t hstepA = (size_t)HALF * g.lda * 2, hstepB = (size_t)HALF * g.ldb * 2;
    const size_t tstepA = 2 * hstepA, tstepB = 2 * hstepB;
    const unsigned ldsw = (unsigned)wid * 1024u;
    const int aoff = lds_byte(wr * 64 + fr, fq * 8), boff = lds_byte(wc * 32 + fr, fq * 8);
#define PG8_SA(b, h) (((b) * 2 + (h)) * HTB)
#define PG8_SB(b, h) ((4 + (b) * 2 + (h)) * HTB)
#define PG8_STAGE(bufoff, gbase, voff) do { _Pragma("unroll") for (int _i = 0; _i < 2; ++_i) \
        __builtin_amdgcn_global_load_lds((const unsigned*)((const char*)(gbase) + (voff)[_i]), (LAS unsigned*)(lds + (bufoff) + ldsw + _i * 8192), 16, 0, 0); } while (0)
#define PG8_LDA(dst, b, h) do { _Pragma("unroll") for (int m = 0; m < 4; ++m) _Pragma("unroll") for (int k = 0; k < 2; ++k) dst[m][k] = *(const LAS bf16x8*)(lds + PG8_SA(b, h) + aoff + m * 2048 + k * 1024); } while (0)
#define PG8_LDB(dst, b, h) do { _Pragma("unroll") for (int n = 0; n < 2; ++n) _Pragma("unroll") for (int k = 0; k < 2; ++k) dst[n][k] = *(const LAS bf16x8*)(lds + PG8_SB(b, h) + boff + n * 2048 + k * 1024); } while (0)
#define PG8_MMA(ai, bj, At, Bt) do { __builtin_amdgcn_s_setprio(1); _Pragma("unroll") for (int m = 0; m < 4; ++m) _Pragma("unroll") for (int n = 0; n < 2; ++n) _Pragma("unroll") for (int k = 0; k < 2; ++k) \
        acc[ai][bj][m][n] = __builtin_amdgcn_mfma_f32_16x16x32_bf16(Bt[n][k], At[m][k], acc[ai][bj][m][n], 0, 0, 0); __builtin_amdgcn_s_setprio(0); } while (0)
#define PG8_WAIT_V(n) asm volatile("s_waitcnt vmcnt(" #n ")" ::: "memory")
#define PG8_WAIT_L(n) asm volatile("s_waitcnt lgkmcnt(" #n ")" ::: "memory")
#define PG8_BAR __builtin_amdgcn_s_barrier()
#define PG8_SCHED __builtin_amdgcn_sched_barrier(0)
    Unit cur, nxt; int ui = 0;
    if (!S.next(0, cur)) return;
    f32x4 acc[2][2][4][2];
#pragma unroll
    for (int a = 0; a < 2; ++a)
#pragma unroll
        for (int b = 0; b < 2; ++b)
#pragma unroll
            for (int m = 0; m < 4; ++m)
#pragma unroll
                for (int n = 0; n < 2; ++n) acc[a][b][m][n] = (f32x4){0.f, 0.f, 0.f, 0.f};
    bf16x8 At[4][2], B0[2][2], B1[2][2];
    const char* cA = (const char*)g.A + (size_t)cur.pm * tstepA; const char* cB = (const char*)g.Bt + (size_t)cur.pn * tstepB;
#if PG8_SP2
    PG8_STAGE(PG8_SB(0, 0), cB, voffB); PG8_STAGE(PG8_SB(0, 1), cB + hstepB, voffB); PG8_STAGE(PG8_SA(0, 0), cA, voffA); PG8_STAGE(PG8_SA(0, 1), cA + hstepA, voffA);
    if (wr == 1) PG8_BAR;
    PG8_WAIT_V(2); PG8_BAR;
    PG8_STAGE(PG8_SB(1, 0), cB + kstep, voffB); PG8_STAGE(PG8_SA(1, 0), cA + kstep, voffA); PG8_STAGE(PG8_SB(1, 1), cB + hstepB + kstep, voffB);
    PG8_WAIT_V(6); PG8_BAR;
#else
    PG8_STAGE(PG8_SB(0, 0), cB, voffB); PG8_STAGE(PG8_SA(0, 0), cA, voffA); PG8_STAGE(PG8_SB(0, 1), cB + hstepB, voffB); PG8_STAGE(PG8_SA(0, 1), cA + hstepA, voffA);
    if (wr == 1) PG8_BAR;
    PG8_WAIT_V(4); PG8_BAR;
    PG8_STAGE(PG8_SB(1, 0), cB + kstep, voffB); PG8_STAGE(PG8_SA(1, 0), cA + kstep, voffA); PG8_STAGE(PG8_SB(1, 1), cB + hstepB + kstep, voffB);
    PG8_WAIT_V(6); PG8_BAR;
#endif
    for (;;) {
        const bool has_next = S.next(ui + 1, nxt);
        const char* nA = has_next ? (const char*)g.A + (size_t)nxt.pm * tstepA : cA; const char* nB = has_next ? (const char*)g.Bt + (size_t)nxt.pn * tstepB : cB;
        for (int t = 0; t < nt; t += 2) {
            const bool last = (t == nt - 2);
            const char* a1 = cA + (size_t)(t + 1) * kstep;
            const char* a2 = last ? nA : cA + (size_t)(t + 2) * kstep; const char* b2 = last ? nB : cB + (size_t)(t + 2) * kstep;
            const char* a3 = a2 + kstep; const char* b3 = b2 + kstep;
#if PG8_SP2
            PG8_LDB(B0, 0, 0); PG8_LDB(B1, 0, 1); PG8_SCHED; PG8_LDA(At, 0, 0); PG8_STAGE(PG8_SA(1, 1), a1 + hstepA, voffA);
            PG8_WAIT_V(8); PG8_WAIT_L(0); PG8_BAR; PG8_MMA(0, 0, At, B0); PG8_MMA(0, 1, At, B1); PG8_BAR; PG8_SCHED;
            PG8_LDA(At, 0, 1); PG8_STAGE(PG8_SB(0, 0), b2, voffB); PG8_STAGE(PG8_SB(0, 1), b2 + hstepB, voffB); PG8_STAGE(PG8_SA(0, 0), a2, voffA);
            PG8_WAIT_V(8); PG8_WAIT_L(0); PG8_BAR; PG8_MMA(1, 0, At, B0); PG8_MMA(1, 1, At, B1); PG8_BAR; PG8_SCHED;
            PG8_LDB(B0, 1, 0); PG8_LDB(B1, 1, 1); PG8_SCHED; PG8_LDA(At, 1, 0); PG8_STAGE(PG8_SA(0, 1), a2 + hstepA, voffA);
            PG8_WAIT_V(8); PG8_WAIT_L(0); PG8_BAR; PG8_MMA(0, 0, At, B0); PG8_MMA(0, 1, At, B1); PG8_BAR; PG8_SCHED;
            PG8_LDA(At, 1, 1); PG8_STAGE(PG8_SB(1, 0), b3, voffB); PG8_STAGE(PG8_SB(1, 1), b3 + hstepB, voffB); PG8_STAGE(PG8_SA(1, 0), a3, voffA);
            PG8_WAIT_V(8); PG8_WAIT_L(0); PG8_BAR; PG8_MMA(1, 0, At, B0); PG8_MMA(1, 1, At, B1); PG8_BAR; PG8_SCHED;
#else
            PG8_LDB(B0, 0, 0); PG8_SCHED; PG8_LDA(At, 0, 0); PG8_STAGE(PG8_SA(1, 1), a1 + hstepA, voffA);
            PG8_WAIT_L(8); PG8_BAR; PG8_WAIT_L(0); PG8_MMA(0, 0, At, B0); PG8_BAR; PG8_SCHED;
            PG8_LDB(B1, 0, 1); PG8_STAGE(PG8_SB(0, 0), b2, voffB);
            PG8_BAR; PG8_WAIT_L(0); PG8_MMA(0, 1, At, B1); PG8_BAR;
            PG8_LDA(At, 0, 1); PG8_STAGE(PG8_SA(0, 0), a2, voffA);
            PG8_BAR; PG8_WAIT_L(0); PG8_MMA(1, 0, At, B0); PG8_BAR; PG8_SCHED;
            PG8_STAGE(PG8_SB(0, 1), b2 + hstepB, voffB);
            PG8_WAIT_V(6); PG8_BAR; PG8_MMA(1, 1, At, B1); PG8_BAR;
            PG8_LDB(B0, 1, 0); PG8_SCHED; PG8_LDA(At, 1, 0); PG8_STAGE(PG8_SA(0, 1), a2 + hstepA, voffA);
            PG8_WAIT_L(8); PG8_BAR; PG8_WAIT_L(0); PG8_MMA(0, 0, At, B0); PG8_BAR; PG8_SCHED;
            PG8_LDB(B1, 1, 1); PG8_STAGE(PG8_SB(1, 0), b3, voffB);
            PG8_BAR; PG8_WAIT_L(0); PG8_MMA(0, 1, At, B1); PG8_BAR;
            PG8_LDA(At, 1, 1); PG8_STAGE(PG8_SA(1, 0), a3, voffA);
            PG8_BAR; PG8_WAIT_L(0); PG8_MMA(1, 0, At, B0); PG8_BAR; PG8_SCHED;
            PG8_STAGE(PG8_SB(1, 1), b3 + hstepB, voffB);
            PG8_WAIT_V(6); PG8_BAR; PG8_MMA(1, 1, At, B1); PG8_BAR;
#endif
        }
        if (wr == 0) PG8_BAR;
        E(acc, cur, wr, wc, fr, fq);
        if (!has_next) break;
#pragma unroll
        for (int a = 0; a < 2; ++a)
#pragma unroll
            for (int b = 0; b < 2; ++b)
#pragma unroll
                for (int m = 0; m < 4; ++m)
#pragma unroll
                    for (int n = 0; n < 2; ++n) acc[a][b][m][n] = (f32x4){0.f, 0.f, 0.f, 0.f};
        cur = nxt; cA = nA; cB = nB; ++ui;
        if (wr == 1) PG8_BAR;
    }
    PG8_WAIT_V(0);
    PG8_BAR;
#undef PG8_SA
#undef PG8_SB
#undef PG8_STAGE
#undef PG8_LDA
#undef PG8_LDB
#undef PG8_MMA
#undef PG8_WAIT_V
#undef PG8_WAIT_L
#undef PG8_BAR
#undef PG8_SCHED
}
}

enum { MAP_PLAIN = 0, MAP_GU = 1, MAP_UQ = 2, MAP_UKV = 3 };
__device__ __forceinline__ int map_row(int mode, int n, int sel) {
    if (mode == MAP_GU) return (n >> 7) * 256 + (n & 127) + sel * 128;
    if (mode == MAP_UQ) { const int h = n / 192, c = n - h * 192; if (c < 128) return n; const int r = c - 128; return h * 192 + 128 + 2 * (r & 31) + (r >> 5); }
    if (mode == MAP_UKV) { const int h = n >> 8, c = n & 255; return (c < 128 ? 0 : 1024) + h * 128 + (c & 127); }
    return n;
}
__device__ __forceinline__ void transpose_item(const float* W, int K, int N, bf16_t* WT, int mode, int sel, LAS float* scr, int item, int lane) {
    const int nblk = N / 32, kb = item / nblk, nb = item - kb * nblk, k0 = 64 * kb, n0 = 32 * nb;
    const int l7 = lane & 7, l3 = lane >> 3;
#pragma unroll
    for (int i = 0; i < 8; ++i) {
        const int kk = l3 + 8 * i;
        const f32x4 v = *(const f32x4*)(W + (size_t)(k0 + kk) * N + n0 + l7 * 4);
        LAS float* s = scr + kk * 33 + l7 * 4;
        s[0] = v[0]; s[1] = v[1]; s[2] = v[2]; s[3] = v[3];
    }
    LDS_WAIT(); asm volatile("" ::: "memory");
#pragma unroll
    for (int j = 0; j < 4; ++j) {
        const int n = l3 + 8 * j; const LAS float* s = scr + (8 * l7) * 33 + n;
        u32x4 o; o.x = cvt_pk_bf16(s[0 * 33], s[1 * 33]); o.y = cvt_pk_bf16(s[2 * 33], s[3 * 33]); o.z = cvt_pk_bf16(s[4 * 33], s[5 * 33]); o.w = cvt_pk_bf16(s[6 * 33], s[7 * 33]);
        *(u32x4*)(WT + (size_t)map_row(mode, n0 + n, sel) * K + k0 + 8 * l7) = o;
    }
    LDS_WAIT(); asm volatile("" ::: "memory");
}

__device__ __forceinline__ void norm_init(const float* xin, const float* pre_g, bf16_t* XB, bf16_t* h, int gw, int NGW, int lane) {
    for (int m = gw; m < M; m += NGW) {
        const float* xr = xin + (size_t)m * D + lane * 4;
        f32x4 xv[8]; float ss = 0.f;
#pragma unroll
        for (int j = 0; j < 8; ++j) { xv[j] = *(const f32x4*)(xr + 256 * j); ss += (xv[j][0] * xv[j][0] + xv[j][1] * xv[j][1]) + (xv[j][2] * xv[j][2] + xv[j][3] * xv[j][3]); }
        const float rs = __builtin_amdgcn_rsqf(wave_sum(ss) * (1.0f / D) + EPS);
        bf16_t* xo = XB + (size_t)m * D + lane * 4; bf16_t* hr = h + (size_t)m * D + lane * 4;
#pragma unroll
        for (int j = 0; j < 8; ++j) { const f32x4 g = *(const f32x4*)(pre_g + lane * 4 + 256 * j); const f32x4 o = xv[j] * g * rs;
            u32x2 w; w.x = cvt_pk_bf16(xv[j][0], xv[j][1]); w.y = cvt_pk_bf16(xv[j][2], xv[j][3]); *(u32x2*)(xo + 256 * j) = w;
            u32x2 v; v.x = cvt_pk_bf16(o[0], o[1]); v.y = cvt_pk_bf16(o[2], o[3]); *(u32x2*)(hr + 256 * j) = v; }
    }
}
__device__ __forceinline__ void norm_phase(bf16_t* XB, const bf16_t* y, float scale, const float* post_g, const float* pre_g, bf16_t* h, float* fout, int gw, int NGW, int lane) {
    f32x4 gp[8], gq[8];
#pragma unroll
    for (int j = 0; j < 8; ++j) { gp[j] = *(const f32x4*)(post_g + lane * 4 + 256 * j); gq[j] = *(const f32x4*)(pre_g + lane * 4 + 256 * j); }
    u32x2 xn[8], yn[8];
    int m = gw;
    if (m < M) {
#pragma unroll
        for (int j = 0; j < 8; ++j) { xn[j] = *(const u32x2*)(XB + (size_t)m * D + lane * 4 + 256 * j); yn[j] = *(const u32x2*)(y + (size_t)m * D + lane * 4 + 256 * j); }
    }
    for (; m < M; m += NGW) {
        f32x4 xv[8], yv[8]; float ss = 0.f;
#pragma unroll
        for (int j = 0; j < 8; ++j) { xv[j] = (f32x4){bf_lo(xn[j].x), bf_hi(xn[j].x), bf_lo(xn[j].y), bf_hi(xn[j].y)}; yv[j] = (f32x4){bf_lo(yn[j].x), bf_hi(yn[j].x), bf_lo(yn[j].y), bf_hi(yn[j].y)};
            ss += (yv[j][0] * yv[j][0] + yv[j][1] * yv[j][1]) + (yv[j][2] * yv[j][2] + yv[j][3] * yv[j][3]); }
        const int m2 = m + NGW;
        if (m2 < M) {
#pragma unroll
            for (int j = 0; j < 8; ++j) { xn[j] = *(const u32x2*)(XB + (size_t)m2 * D + lane * 4 + 256 * j); yn[j] = *(const u32x2*)(y + (size_t)m2 * D + lane * 4 + 256 * j); }
        }
        const float rs = scale * __builtin_amdgcn_rsqf(wave_sum(ss) * (1.0f / D) + EPS);
        float s2 = 0.f;
#pragma unroll
        for (int j = 0; j < 8; ++j) { xv[j] = xv[j] + yv[j] * gp[j] * rs; s2 += (xv[j][0] * xv[j][0] + xv[j][1] * xv[j][1]) + (xv[j][2] * xv[j][2] + xv[j][3] * xv[j][3]); }
        if (fout) {
            float* fo = fout + (size_t)m * D + lane * 4;
#pragma unroll
            for (int j = 0; j < 8; ++j) *(f32x4*)(fo + 256 * j) = xv[j];
        } else {
            const float r2 = __builtin_amdgcn_rsqf(wave_sum(s2) * (1.0f / D) + EPS);
            bf16_t* xo = XB + (size_t)m * D + lane * 4; bf16_t* hr = h + (size_t)m * D + lane * 4;
#pragma unroll
            for (int j = 0; j < 8; ++j) { const f32x4 o = xv[j] * gq[j] * r2;
                u32x2 w; w.x = cvt_pk_bf16(xv[j][0], xv[j][1]); w.y = cvt_pk_bf16(xv[j][2], xv[j][3]); *(u32x2*)(xo + 256 * j) = w;
                u32x2 v; v.x = cvt_pk_bf16(o[0], o[1]); v.y = cvt_pk_bf16(o[2], o[3]); *(u32x2*)(hr + 256 * j) = v; }
        }
    }
}

__device__ __forceinline__ void prep_phase(bf16_t* P, const float* qg, const float* kvg, const float* cs, int gw, int NGW, int lane) {
    for (int m = gw; m < M; m += NGW) {
        bf16_t* pr = P + (size_t)m * P_LD;
#pragma unroll
        for (int part = 0; part < 2; ++part) {
            bf16_t* q = pr + part * 512 + lane * 8;
            const float* g = (part ? kvg : qg) + lane * 8;
            const u32x4 t = *(const u32x4*)q;
            float v[8] = {bf_lo(t.x), bf_hi(t.x), bf_lo(t.y), bf_hi(t.y), bf_lo(t.z), bf_hi(t.z), bf_lo(t.w), bf_hi(t.w)};
            float ss = 0.f;
#pragma unroll
            for (int e = 0; e < 8; ++e) ss += v[e] * v[e];
            const float rs = __builtin_amdgcn_rsqf(wave_sum(ss) * (1.0f / 512.0f) + EPS);
            const f32x4 g0 = *(const f32x4*)g, g1 = *(const f32x4*)(g + 4);
            u32x4 o; o.x = cvt_pk_bf16(v[0] * rs * g0[0], v[1] * rs * g0[1]); o.y = cvt_pk_bf16(v[2] * rs * g0[2], v[3] * rs * g0[3]);
            o.z = cvt_pk_bf16(v[4] * rs * g1[0], v[5] * rs * g1[1]); o.w = cvt_pk_bf16(v[6] * rs * g1[2], v[7] * rs * g1[3]);
            *(u32x4*)q = o;
        }
        if (lane < 32) {
            const float x1 = bf_lo((unsigned)pr[OFF_KR + lane]), x2 = bf_lo((unsigned)pr[OFF_KR + 32 + lane]);
            const f32x2 c = *(const f32x2*)(cs + (size_t)m * 64 + lane * 2);
            *(unsigned*)(pr + OFF_KPE + 2 * lane) = cvt_pk_bf16(x1 * c[0] - x2 * c[1], x2 * c[0] + x1 * c[1]);
        }
    }
}

__device__ __forceinline__ void conv_phase(LAS unsigned char* lds, const bf16_t* P, const float* cw, const float* cb, const float* ng, const float* nb, bf16_t* CAT, int bid, int G, const int tid) {
    LAS float* zs = (LAS float*)lds;
    LAS float* co = (LAS float*)(lds + 94 * 128 * 4);
    const int lane = tid & 63, w = tid >> 6;
    u32x4 ra[3], rg[3];
#define CONV_LOAD(uu) do { const int g_ = (uu) & 7, tt_ = ((uu) >> 3) & 31, b_ = (uu) >> 8; \
        _Pragma("unroll") for (int i = 0; i < 3; ++i) { const int ch = tid + 512 * i, r = ch >> 4, c8 = ch & 15, t = tt_ * 64 - 30 + r; \
            ra[i] = (u32x4){0u, 0u, 0u, 0u}; rg[i] = (u32x4){0u, 0u, 0u, 0u}; \
            if (ch < 94 * 16 && t >= 0) { const bf16_t* src = P + (size_t)(b_ * SEQ + t) * P_LD + g_ * 128 + c8 * 8; ra[i] = *(const u32x4*)(src + OFF_CONV); rg[i] = *(const u32x4*)(src + OFF_GATE); } } } while (0)
    if (bid < 4096) CONV_LOAD(bid);
    for (int u = bid; u < 4096; u += G) {
        const int g = u & 7, tt = (u >> 3) & 31, b = u >> 8, t0 = tt * 64;
#pragma unroll
        for (int i = 0; i < 3; ++i) {
            const int ch = tid + 512 * i, r = ch >> 4, c8 = ch & 15;
            if (ch < 94 * 16) {
                const u32x4 a = ra[i], gt = rg[i];
                f32x4 z0, z1;
                z0[0] = bf_lo(a.x) * fast_sigmoid(bf_lo(gt.x)); z0[1] = bf_hi(a.x) * fast_sigmoid(bf_hi(gt.x));
                z0[2] = bf_lo(a.y) * fast_sigmoid(bf_lo(gt.y)); z0[3] = bf_hi(a.y) * fast_sigmoid(bf_hi(gt.y));
                z1[0] = bf_lo(a.z) * fast_sigmoid(bf_lo(gt.z)); z1[1] = bf_hi(a.z) * fast_sigmoid(bf_hi(gt.z));
                z1[2] = bf_lo(a.w) * fast_sigmoid(bf_lo(gt.w)); z1[3] = bf_hi(a.w) * fast_sigmoid(bf_hi(gt.w));
                *(LAS f32x4*)(zs + r * 128 + c8 * 8) = z0; *(LAS f32x4*)(zs + r * 128 + c8 * 8 + 4) = z1;
            }
        }
        __syncthreads();
        if (u + G < 4096) CONV_LOAD(u + G);
        {
            const int c = tid & 127, tb = tid >> 7;
            float wj[31];
#pragma unroll
            for (int j = 0; j < 31; ++j) wj[j] = cw[j * 1024 + g * 128 + c];
            const float bias = cb[g * 128 + c];
            float acc[16];
#pragma unroll
            for (int o = 0; o < 16; ++o) acc[o] = bias;
#pragma unroll
            for (int i = 0; i < 46; ++i) {
                const float z = zs[(tb * 16 + i) * 128 + c];
#pragma unroll
                for (int o = 0; o < 16; ++o) { const int j = i - o; if (j >= 0 && j <= 30) acc[o] += wj[j] * z; }
            }
#pragma unroll
            for (int o = 0; o < 16; ++o) co[(tb * 16 + o) * 128 + c] = acc[o];
        }
        __syncthreads();
        {
            const f32x2 gg = *(const f32x2*)(ng + g * 128 + 2 * lane), bb = *(const f32x2*)(nb + g * 128 + 2 * lane);
#pragma unroll
            for (int k = 0; k < 8; ++k) {
                const int tok = w * 8 + k;
                const f32x2 v = *(const LAS f32x2*)(co + tok * 128 + 2 * lane);
                const float mean = wave_sum(v[0] + v[1]) * (1.0f / 128.0f);
                const float d0 = v[0] - mean, d1 = v[1] - mean;
                const float rs = __builtin_amdgcn_rsqf(wave_sum(d0 * d0 + d1 * d1) * (1.0f / 128.0f) + EPS);
                const float y0 = d0 * rs * gg[0] + bb[0], y1 = d1 * rs * gg[1] + bb[1];
                *(unsigned*)(CAT + (size_t)(b * SEQ + t0 + tok) * D + 1024 + g * 128 + 2 * lane) = cvt_pk_bf16(silu_f(y0), silu_f(y1));
            }
        }
    }
#undef CONV_LOAD
    __syncthreads();
}

__device__ __forceinline__ void attn_phase(LAS unsigned char* lds, const bf16_t* Q, const bf16_t* KN, const bf16_t* P, const bf16_t* VT, bf16_t* CAT, int bid, int G, const int tid) {
    constexpr int KS = 200, VS = 72, KBYTES = 64 * KS * 2, VBYTES = 128 * VS * 2, BUFB = KBYTES + VBYTES;
    const int lane = tid & 63, w = __builtin_amdgcn_readfirstlane(tid >> 6), fr = lane & 15, fq = lane >> 4;
    for (int u = bid; u < 1024; u += G) {
        const int rnd = u >> 8, c = u & 255, bh = c >> 1, half = c & 1;
        const int qb = half ? (rnd == 0 ? 5 : rnd == 1 ? 2 : rnd == 2 ? 4 : 3) : (rnd == 0 ? 7 : rnd == 1 ? 0 : rnd == 2 ? 6 : 1);
        const int b = bh >> 3, hh = bh & 7, nt = 4 * (qb + 1);
        const size_t tok0 = (size_t)b * SEQ;
        const int qlo = qb * 256 + 32 * w;
        bf16x8 qf[2][6];
#pragma unroll
        for (int qi = 0; qi < 2; ++qi)
#pragma unroll
            for (int ch = 0; ch < 6; ++ch) qf[qi][ch] = *(const bf16x8*)(Q + (tok0 + qlo + 16 * qi + fr) * QW + hh * 192 + ch * 32 + fq * 8);
        f32x4 o[8][2];
#pragma unroll
        for (int d = 0; d < 8; ++d) { o[d][0] = (f32x4){0.f, 0.f, 0.f, 0.f}; o[d][1] = (f32x4){0.f, 0.f, 0.f, 0.f}; }
        float mrow[2] = {-INFINITY, -INFINITY}, lrow[2] = {0.f, 0.f};
        const int kkey0 = tid >> 4, kc16 = tid & 15;
        const int pkey = tid >> 3, pc8 = tid & 7;
        const int vd0 = tid >> 3, vc8 = tid & 7;
        const bf16_t* gk = KN + (tok0 + kkey0) * 1024 + hh * 128 + kc16 * 8;
        const bf16_t* gp = P + (tok0 + pkey) * P_LD + OFF_KPE + pc8 * 8;
        const bf16_t* gv = VT + (size_t)(hh * 128 + vd0) * M + tok0 + vc8 * 8;
        const int lk = (kkey0 * KS + kc16 * 8) * 2, lp = (pkey * KS + 128 + pc8 * 8) * 2, lv = KBYTES + (vd0 * VS + vc8 * 8) * 2;
        u32x4 rk0, rk1, rp, rv0, rv1;
        rk0 = *(const u32x4*)(gk); rk1 = *(const u32x4*)(gk + 32 * 1024); rp = *(const u32x4*)(gp);
        rv0 = *(const u32x4*)(gv); rv1 = *(const u32x4*)(gv + (size_t)64 * M);
        for (int kt = 0; kt < nt; ++kt) {
            LAS unsigned char* buf = lds + (kt & 1) * BUFB;
            *(LAS u32x4*)(buf + lk) = rk0; *(LAS u32x4*)(buf + lk + 32 * KS * 2) = rk1; *(LAS u32x4*)(buf + lp) = rp;
            *(LAS u32x4*)(buf + lv) = rv0; *(LAS u32x4*)(buf + lv + 64 * VS * 2) = rv1;
            __syncthreads();
            if (kt + 1 < nt) {
                const size_t ko = (size_t)(kt + 1) * 64;
                rk0 = *(const u32x4*)(gk + ko * 1024); rk1 = *(const u32x4*)(gk + (ko + 32) * 1024); rp = *(const u32x4*)(gp + ko * P_LD);
                rv0 = *(const u32x4*)(gv + ko); rv1 = *(const u32x4*)(gv + (size_t)64 * M + ko);
            }
            if (kt * 64 <= qlo + 31) {
                f32x4 s[4][2];
#pragma unroll
                for (int kb = 0; kb < 4; ++kb) { s[kb][0] = (f32x4){0.f, 0.f, 0.f, 0.f}; s[kb][1] = (f32x4){0.f, 0.f, 0.f, 0.f}; }
#pragma unroll
                for (int ch = 0; ch < 6; ++ch) {
#pragma unroll
                    for (int kb = 0; kb < 4; ++kb) {
                        const bf16x8 kf = *(const LAS bf16x8*)(buf + ((kb * 16 + fr) * KS + ch * 32 + fq * 8) * 2);
                        s[kb][0] = __builtin_amdgcn_mfma_f32_16x16x32_bf16(kf, qf[0][ch], s[kb][0], 0, 0, 0);
                        s[kb][1] = __builtin_amdgcn_mfma_f32_16x16x32_bf16(kf, qf[1][ch], s[kb][1], 0, 0, 0);
                    }
                    if (ch & 1) asm volatile("" ::: "memory");
                }
                if (kt * 64 + 63 > qlo) {
#pragma unroll
                    for (int kb = 0; kb < 4; ++kb)
#pragma unroll
                        for (int qi = 0; qi < 2; ++qi)
#pragma unroll
                            for (int j = 0; j < 4; ++j) { const int key = kt * 64 + kb * 16 + fq * 4 + j, q = qlo + qi * 16 + fr; if (key > q) s[kb][qi][j] = -INFINITY; }
                }
                bf16x8 pf[2][2];
#pragma unroll
                for (int qi = 0; qi < 2; ++qi) {
                    float mx = -INFINITY;
#pragma unroll
                    for (int kb = 0; kb < 4; ++kb) mx = fmaxf(mx, fmaxf(fmaxf(s[kb][qi][0], s[kb][qi][1]), fmaxf(s[kb][qi][2], s[kb][qi][3])));
                    mx = fmaxf(mx, __shfl_xor(mx, 16)); mx = fmaxf(mx, __shfl_xor(mx, 32));
                    const float mnew = fmaxf(mrow[qi], mx);
                    const float alpha = __builtin_amdgcn_exp2f(mrow[qi] - mnew);
                    mrow[qi] = mnew;
                    float ps = 0.f;
#pragma unroll
                    for (int kb = 0; kb < 4; ++kb)
#pragma unroll
                        for (int j = 0; j < 4; ++j) { const float e = __builtin_amdgcn_exp2f(s[kb][qi][j] - mnew); s[kb][qi][j] = e; ps += e; }
                    lrow[qi] = lrow[qi] * alpha + ps;
#pragma unroll
                    for (int d = 0; d < 8; ++d) o[d][qi] = o[d][qi] * alpha;
#pragma unroll
                    for (int cc = 0; cc < 2; ++cc) {
                        u32x4 t; t.x = cvt_pk_bf16(s[2 * cc][qi][0], s[2 * cc][qi][1]); t.y = cvt_pk_bf16(s[2 * cc][qi][2], s[2 * cc][qi][3]);
                        t.z = cvt_pk_bf16(s[2 * cc + 1][qi][0], s[2 * cc + 1][qi][1]); t.w = cvt_pk_bf16(s[2 * cc + 1][qi][2], s[2 * cc + 1][qi][3]);
                        pf[qi][cc] = __builtin_bit_cast(bf16x8, t);
                    }
                }
#pragma unroll
                for (int cc = 0; cc < 2; ++cc)
#pragma unroll
                    for (int d = 0; d < 8; ++d) {
                        const LAS unsigned char* vp = buf + KBYTES + ((d * 16 + fr) * VS + 32 * cc + 4 * fq) * 2;
                        const u32x2 v0 = *(const LAS u32x2*)vp, v1 = *(const LAS u32x2*)(vp + 32);
                        const u32x4 vv = {v0.x, v0.y, v1.x, v1.y};
                        const bf16x8 vf = __builtin_bit_cast(bf16x8, vv);
                        o[d][0] = __builtin_amdgcn_mfma_f32_16x16x32_bf16(vf, pf[0][cc], o[d][0], 0, 0, 0);
                        o[d][1] = __builtin_amdgcn_mfma_f32_16x16x32_bf16(vf, pf[1][cc], o[d][1], 0, 0, 0);
                    }
            }
        }
#pragma unroll
        for (int qi = 0; qi < 2; ++qi) {
            float l = lrow[qi]; l += __shfl_xor(l, 16); l += __shfl_xor(l, 32);
            const float inv = 1.0f / l;
            bf16_t* op = CAT + (tok0 + qlo + 16 * qi + fr) * D + hh * 128 + fq * 4;
#pragma unroll
            for (int d = 0; d < 8; ++d) { const f32x4 v = o[d][qi] * inv; u32x2 t; t.x = cvt_pk_bf16(v[0], v[1]); t.y = cvt_pk_bf16(v[2], v[3]); *(u32x2*)(op + d * 16) = t; }
        }
    }
    __syncthreads();
}

__device__ __forceinline__ void sgu_phase(LAS unsigned char* lds, const bf16_t* U, const bf16_t* VTg, const float* vg, const float* vb, const float* wsp, const float* bsp, bf16_t* Gout, int bid, int G, const int tid) {
    constexpr int RS = 136;
    LAS bf16_t* Ws = (LAS bf16_t*)lds;
    LAS bf16_t* Vs = (LAS bf16_t*)(lds + 128 * RS * 2);
    LAS float* red = (LAS float*)(lds + 128 * RS * 2);
    LAS float* st = (LAS float*)(lds + 128 * RS * 2 + 256 * RS * 2);
    const int lane = tid & 63, w = __builtin_amdgcn_readfirstlane(tid >> 6), fr = lane & 15, fq = lane >> 4;
    for (int ci = bid; ci < 256; ci += G) {
        const size_t r0 = (size_t)ci * 128;
        {
            const int rg = tid >> 4, tc = tid & 15;
            float s1[8], s2[8];
#pragma unroll
            for (int e = 0; e < 8; ++e) { s1[e] = 0.f; s2[e] = 0.f; }
#pragma unroll 8
            for (int pass = 0; pass < 64; ++pass) {
                const u32x4 t = *(const u32x4*)((const char*)(VTg + (size_t)(pass * 32) * M + r0) + (unsigned)((rg * M + tc * 8) * 2));
                const float v[8] = {bf_lo(t.x), bf_hi(t.x), bf_lo(t.y), bf_hi(t.y), bf_lo(t.z), bf_hi(t.z), bf_lo(t.w), bf_hi(t.w)};
#pragma unroll
                for (int e = 0; e < 8; ++e) { s1[e] += v[e]; s2[e] += v[e] * v[e]; }
            }
#pragma unroll
            for (int e = 0; e < 8; ++e) *(LAS f32x2*)(red + (rg * 128 + tc * 8 + e) * 2) = (f32x2){s1[e], s2[e]};
        }
        __syncthreads();
        if (tid < 128) {
            float a = 0.f, q = 0.f;
#pragma unroll 8
            for (int rg = 0; rg < 32; ++rg) { const f32x2 t = *(const LAS f32x2*)(red + (rg * 128 + tid) * 2); a += t[0]; q += t[1]; }
            const float mean = a * (1.0f / 2048.0f), var = fmaxf(q * (1.0f / 2048.0f) - mean * mean, 0.f);
            *(LAS f32x2*)(st + tid * 2) = (f32x2){mean, __builtin_amdgcn_rsqf(var + EPS)};
        }
        __syncthreads();
        f32x4 wreg[8]; u32x4 vreg[8]; float gar[8], ber[8];
        const unsigned voffW = (unsigned)(((tid >> 5) * 128 + (tid & 31) * 4) * 4), voffV = (unsigned)(((tid >> 4) * M + (tid & 15) * 8) * 2), voffG = (unsigned)((tid >> 4) * 4);
#define SGU_LOAD(gg) do { _Pragma("unroll") for (int i = 0; i < 8; ++i) { \
            const char* bw = (const char*)(wsp + (size_t)(gg) * 16384 + i * 2048); wreg[i] = *(const f32x4*)(bw + voffW); \
            const char* bv = (const char*)(VTg + (size_t)((gg) * 256 + 32 * i) * M + r0); vreg[i] = *(const u32x4*)(bv + voffV); \
            gar[i] = *(const float*)((const char*)(vg + (gg) * 256 + 32 * i) + voffG); ber[i] = *(const float*)((const char*)(vb + (gg) * 256 + 32 * i) + voffG); } } while (0)
        SGU_LOAD(0);
        for (int g = 0; g < 8; ++g) {
#pragma unroll
            for (int i = 0; i < 8; ++i) {
                const int idx = tid + 512 * i, t = idx >> 5, s4 = (idx & 31) * 4;
                f32x4 v = wreg[i];
#pragma unroll
                for (int e = 0; e < 4; ++e) if (s4 + e > t) v[e] = 0.f;
                u32x2 o; o.x = cvt_pk_bf16(v[0], v[1]); o.y = cvt_pk_bf16(v[2], v[3]);
                *(LAS u32x2*)(Ws + t * RS + s4) = o;
            }
#pragma unroll
            for (int i = 0; i < 8; ++i) {
                const int idx = tid + 512 * i, d = idx >> 4, tc = idx & 15;
                const u32x4 t = vreg[i];
                const float ga = gar[i], be = ber[i];
                float v[8] = {bf_lo(t.x), bf_hi(t.x), bf_lo(t.y), bf_hi(t.y), bf_lo(t.z), bf_hi(t.z), bf_lo(t.w), bf_hi(t.w)};
#pragma unroll
                for (int e = 0; e < 8; ++e) { const f32x2 ms = *(const LAS f32x2*)(st + (tc * 8 + e) * 2); v[e] = (v[e] - ms[0]) * ms[1] * ga + be; }
                u32x4 o; o.x = cvt_pk_bf16(v[0], v[1]); o.y = cvt_pk_bf16(v[2], v[3]); o.z = cvt_pk_bf16(v[4], v[5]); o.w = cvt_pk_bf16(v[6], v[7]);
                *(LAS u32x4*)(Vs + d * RS + tc * 8) = o;
            }
            __syncthreads();
            if (g + 1 < 8) SGU_LOAD(g + 1);
#pragma unroll 1
            for (int hf = 0; hf < 2; ++hf) {
                u32x2 ureg[8];
                const int t = 16 * w + fr;
                const unsigned voffU = (unsigned)((t * D + fq * 4) * 2);
                const char* bu = (const char*)(U + r0 * D + g * 256 + hf * 128); char* bg = (char*)(Gout + r0 * D + g * 256 + hf * 128);
#pragma unroll
                for (int d = 0; d < 8; ++d) ureg[d] = *(const u32x2*)(bu + voffU + d * 32);
                f32x4 acc[8];
#pragma unroll
                for (int d = 0; d < 8; ++d) acc[d] = (f32x4){0.f, 0.f, 0.f, 0.f};
                const int nsc = (w >> 1) + 1;
                for (int sc = 0; sc < nsc; ++sc) {
                    const bf16x8 wf = *(const LAS bf16x8*)(Ws + (16 * w + fr) * RS + sc * 32 + fq * 8);
#pragma unroll
                    for (int d = 0; d < 8; ++d) {
                        const bf16x8 vf = *(const LAS bf16x8*)(Vs + ((hf * 8 + d) * 16 + fr) * RS + sc * 32 + fq * 8);
                        acc[d] = __builtin_amdgcn_mfma_f32_16x16x32_bf16(vf, wf, acc[d], 0, 0, 0);
                    }
                }
                const float bias = bsp[g * 128 + t];
#pragma unroll
                for (int d = 0; d < 8; ++d) {
                    const u32x2 uu = ureg[d];
                    u32x2 o; o.x = cvt_pk_bf16(bf_lo(uu.x) * (acc[d][0] + bias), bf_hi(uu.x) * (acc[d][1] + bias));
                    o.y = cvt_pk_bf16(bf_lo(uu.y) * (acc[d][2] + bias), bf_hi(uu.y) * (acc[d][3] + bias));
                    *(u32x2*)(bg + voffU + d * 32) = o;
                }
            }
            __syncthreads();
        }
#undef SGU_LOAD
    }
}

#define XB_TMO      128
#define XB_XCNT(j)  (256  + 64 * (j))
#define XB_XSUB(j)  (1280 + 64 * (j))
#define XB_XGEN(j)  (2304 + 64 * (j))
#define XB_TOP      3328
#define XB_TOPGEN   3392
#define XCD_BAR_WORDS 3456
#define XB_SPIN_CAP (1u << 22)
__device__ __forceinline__ unsigned xb_ld(unsigned* p)              { return __hip_atomic_load(p, __ATOMIC_RELAXED, __HIP_MEMORY_SCOPE_AGENT); }
__device__ __forceinline__ unsigned xb_add(unsigned* p, unsigned v) { return __hip_atomic_fetch_add(p, v, __ATOMIC_RELAXED, __HIP_MEMORY_SCOPE_AGENT); }
__device__ __forceinline__ unsigned xb_xcc_id() { return (unsigned)__builtin_amdgcn_s_getreg((3 << 11) | 20) & 0xFu; }
#define XB_SPIN(cond, bar) do { unsigned _sp = 0; while (cond) { __builtin_amdgcn_s_sleep(1); \
    if ((++_sp & 255u) == 0u) { if (xb_ld(&(bar)[XB_TMO])) break; if (_sp > XB_SPIN_CAP) { atomicAdd(&(bar)[XB_TMO], 1u); break; } } } } while (0)
struct XcdBarrier { unsigned* bar; unsigned x; volatile LAS unsigned* st; };
__device__ __forceinline__ XcdBarrier xcd_barrier_post(unsigned* bar, volatile LAS unsigned* st) {
    XcdBarrier b; b.bar = bar; b.x = xb_xcc_id(); b.st = st;
    if (threadIdx.x == 0) (void)xb_add(&bar[XB_XCNT(b.x)], 1u);
    return b;
}
__device__ __forceinline__ void xcd_barrier_complete(unsigned* bar, unsigned x, unsigned& nloc, unsigned& nx) {
    const unsigned G = gridDim.x * gridDim.y * gridDim.z;
    unsigned sum, cnt, mine, sp = 0u;
    for (;;) {
        sum = 0u; cnt = 0u; mine = 0u;
#pragma unroll
        for (unsigned j = 0; j < 16; ++j) { const unsigned c = xb_ld(&bar[XB_XCNT(j)]); sum += c; cnt += (c > 0u) ? 1u : 0u; mine = (j == x) ? c : mine; }
        if (sum == G) break;
        __builtin_amdgcn_s_sleep(1);
        if ((++sp & 255u) == 0u) { if (xb_ld(&bar[XB_TMO])) break; if (sp > XB_SPIN_CAP) { atomicAdd(&bar[XB_TMO], 1u); break; } }
    }
    nloc = mine > 0u ? mine : 1u; nx = cnt > 0u ? cnt : 1u;
}
__device__ __forceinline__ void xcd_barrier(const XcdBarrier& b) {
    asm volatile("s_waitcnt vmcnt(0)" ::: "memory");
    __syncthreads();
    if (threadIdx.x == 0) {
        unsigned* bar = b.bar;
        __builtin_amdgcn_s_waitcnt(0);
        unsigned nloc = b.st[0], nx = b.st[1];
        if (nloc == 0u) { xcd_barrier_complete(bar, b.x, nloc, nx); b.st[0] = nloc; b.st[1] = nx; }
        const unsigned old = xb_add(&bar[XB_XSUB(b.x)], 1u);
        const unsigned gen = old / nloc;
        if (old + 1u == (gen + 1u) * nloc) {
            __builtin_amdgcn_fence(__ATOMIC_RELEASE, "agent");
            asm volatile("s_waitcnt vmcnt(0)" ::: "memory");
            const unsigned og = xb_add(&bar[XB_TOP], 1u);
            const unsigned tg = og / nx;
            if (og + 1u == (tg + 1u) * nx) xb_add(&bar[XB_TOPGEN], 1u);
            else XB_SPIN(xb_ld(&bar[XB_TOPGEN]) == tg, bar);
            __builtin_amdgcn_fence(__ATOMIC_ACQUIRE, "agent");
            xb_add(&bar[XB_XGEN(b.x)], 1u);
            asm volatile("s_waitcnt vmcnt(0)" ::: "memory");
        } else {
            XB_SPIN(xb_ld(&bar[XB_XGEN(b.x)]) == gen, bar);
            __builtin_amdgcn_fence(__ATOMIC_ACQUIRE, "agent");
            asm volatile("s_waitcnt vmcnt(0)" ::: "memory");
        }
    }
    __syncthreads();
}

template <int OFF> __device__ __forceinline__ const void* karg_ptr() {
    const unsigned long long base = (unsigned long long)__builtin_amdgcn_kernarg_segment_ptr();
    unsigned long long r;
    asm volatile("s_load_dwordx2 %0, %1, %2\n\ts_waitcnt lgkmcnt(0)" : "=s"(r) : "s"(base), "n"(OFF) : "memory");
    return (const void*)r;
}
__device__ __forceinline__ const void* karg_ptr_dyn(int off) {
    const unsigned long long base = (unsigned long long)__builtin_amdgcn_kernarg_segment_ptr();
    unsigned long long r; const int o = __builtin_amdgcn_readfirstlane(off);
    asm volatile("s_load_dwordx2 %0, %1, %2\n\ts_waitcnt lgkmcnt(0)" : "=s"(r) : "s"(base), "s"(o) : "memory");
    return (const void*)r;
}
template <int OFF> __device__ __forceinline__ int karg_int() {
    const unsigned long long base = (unsigned long long)__builtin_amdgcn_kernarg_segment_ptr();
    int r;
    asm volatile("s_load_dword %0, %1, %2\n\ts_waitcnt lgkmcnt(0)" : "=s"(r) : "s"(base), "n"(OFF) : "memory");
    return r;
}
#define INP(k) ((const float*)karg_ptr<8 * (k)>())
#define KARG_OUT ((float*)karg_ptr<256>())
#define KARG_WS ((unsigned char*)karg_ptr<264>())

struct Params {
    const float* in[32];
    float* out; unsigned char* ws;
    float inv_freq[32];
    int ph_lo, ph_hi;
};

static_assert(offsetof(Params, out) == 256 && offsetof(Params, ws) == 264 && offsetof(Params, inv_freq) == 272 && offsetof(Params, ph_lo) == 400 && offsetof(Params, ph_hi) == 404 && sizeof(Params) == 408, "kernarg layout");
__global__ void __launch_bounds__(512, 2) mk_fwd(Params p) {
    extern __shared__ __attribute__((aligned(16))) unsigned char lds_raw[];
    LAS unsigned char* lds = (LAS unsigned char*)lds_raw;
    cg::grid_group grid = cg::this_grid();
    const float qscale = 0.07216878364870322f * 1.4426950408889634f;

    const int ph_lo = karg_int<400>(), ph_hi = karg_int<404>();
    volatile LAS unsigned* bst = (volatile LAS unsigned*)(lds + 131072 + 1024);
    if (threadIdx.x < 4) bst[threadIdx.x] = 0u;
    __syncthreads();
    const unsigned xcc_once = xb_xcc_id();
#define GRID_BAR() do { XcdBarrier b_; b_.bar = (unsigned*)KARG_WS; b_.x = xcc_once; b_.st = (volatile LAS unsigned*)(lds + 131072 + 1024); xcd_barrier(b_); } while (0)
    if (ph_hi - ph_lo > 1) {
        if (blockIdx.x == 0) {
            unsigned* bw = (unsigned*)KARG_WS;
            for (int i = threadIdx.x; i < XCD_BAR_WORDS; i += 512) __hip_atomic_store(bw + i, 0u, __ATOMIC_RELAXED, __HIP_MEMORY_SCOPE_AGENT);
            __threadfence();
        }
        grid.sync();
        if (threadIdx.x == 0) (void)xb_add(&((unsigned*)KARG_WS)[XB_XCNT(xcc_once)], 1u);
    }
    int rep = 0;
    for (int ph = ph_lo; ph < ph_hi;) {
        int tid = threadIdx.x, bid = blockIdx.x, G = gridDim.x;
        asm volatile("" : "+v"(tid)); asm volatile("" : "+s"(bid)); asm volatile("" : "+s"(G));
        const int lane = tid & 63, wave = __builtin_amdgcn_readfirstlane(tid >> 6);
        const int gw = bid * 8 + wave, NGW = G * 8;
        unsigned char* ws = KARG_WS;
        bf16_t* const XB = (bf16_t*)(ws + WS_H);
        bf16_t* const H = (bf16_t*)KARG_OUT;
        bf16_t* const Y = (bf16_t*)(ws + WS_Y);
        bf16_t* const ACT = (bf16_t*)(ws + WS_ACT);
        bf16_t* const Pb = ACT;
        bf16_t* const Qb = ACT + (size_t)M * P_LD;
        bf16_t* const KNb = Y;
        bf16_t* const VTb = Y + (size_t)M * 1024;
        bf16_t* const Ub = ACT;
        bf16_t* const VTo = ACT + (size_t)M * 2048;
        float* const CS = (float*)(ws + WS_CS);
        int type = 0, ab = 0, l = 0, sub = 0;
        switch (ph) {
            case 0: type = 0; break;
            case 1: type = 1; ab = 0; l = 0; break;
            case 2: type = 2; sub = 0; ab = 0; l = 0; break;
            case 3: type = 3; sub = 0; break;
            case 4: type = 2; sub = 1; break;
            case 5: type = 4; break;
            case 6: type = 5; break;
            case 7: type = 6; break;
            case 8: type = 2; sub = 2; break;
            case 9: type = 3; sub = 1; break;
            case 10: type = 1; ab = 1; l = 0; break;
            case 11: type = 2; sub = 0; ab = 1; l = 0; break;
            case 12: type = 3; sub = 2; break;
            case 13: type = 1; ab = 0; l = 1; break;
            case 14: type = 2; sub = 0; ab = 0; l = 1; break;
            case 15: type = 3; sub = 3; break;
            case 16: type = 7; break;
            case 17: type = 8; break;
            case 18: type = 2; sub = 3; break;
            case 19: type = 3; sub = 4; break;
            case 20: type = 1; ab = 1; l = 1; break;
            case 21: type = 2; sub = 0; ab = 1; l = 1; break;
            default: type = 3; sub = 5; break;
        }
        const int reps = ((REPEAT_MASK >> type) & 1) ? 2 : 1;
        if (type == 0) {
            LAS float* scr = (LAS float*)(lds + wave * 16384);
            constexpr int I_FFN = 5632, I_WIN_E = 32 * 98, I_UQ = 8 * 48, I_UKV = 8 * 64, I_SQ = 32 * 64, I_WIN_O = 32 * 128;
            constexpr int NITEMS = 12 * I_FFN + I_WIN_E + I_UQ + I_UKV + I_SQ + I_WIN_O + I_SQ;
            for (int it = gw; it < NITEMS; it += NGW) {
                int r = it;
                if (r < 12 * I_FFN) {
                    const int mi = r / I_FFN; r -= mi * I_FFN;
                    const int fab = mi / 6, rem = mi - fab * 6, fl = rem / 3, kind = rem - fl * 3;
                    const float* src = (const float*)karg_ptr_dyn(8 * (4 + fab * 5 + kind));
                    src += (size_t)fl * D * FF;
                    if (kind < 2) transpose_item(src, D, FF, (bf16_t*)(ws + WS_WGU + (size_t)(fab * 2 + fl) * 44 * MiB), MAP_GU, kind, scr, r, lane);
                    else transpose_item(src, FF, D, (bf16_t*)(ws + WS_WD + (size_t)(fab * 2 + fl) * 22 * MiB), MAP_PLAIN, 0, scr, r, lane);
                    continue;
                }
                r -= 12 * I_FFN;
                if (r < I_WIN_E) { transpose_item(INP(14), D, 3136, (bf16_t*)(ws + WS_WIN_E), MAP_PLAIN, 0, scr, r, lane); continue; } r -= I_WIN_E;
                if (r < I_UQ) { transpose_item(INP(17), 512, QW, (bf16_t*)(ws + WS_WUQ), MAP_UQ, 0, scr, r, lane); continue; } r -= I_UQ;
                if (r < I_UKV) { transpose_item(INP(18), 512, 2048, (bf16_t*)(ws + WS_WUKV), MAP_UKV, 0, scr, r, lane); continue; } r -= I_UKV;
                if (r < I_SQ) { transpose_item(INP(23), D, D, (bf16_t*)(ws + WS_WOUT_E), MAP_PLAIN, 0, scr, r, lane); continue; } r -= I_SQ;
                if (r < I_WIN_O) { transpose_item(INP(26), D, 4096, (bf16_t*)(ws + WS_WIN_O), MAP_PLAIN, 0, scr, r, lane); continue; } r -= I_WIN_O;
                transpose_item(INP(31), D, D, (bf16_t*)(ws + WS_WOUT_O), MAP_PLAIN, 0, scr, r, lane);
            }
            {
                u32x4* z = (u32x4*)(ws + WS_WIN_E + (size_t)3136 * D * 2);
                const int nz = 192 * D * 2 / 16;
                for (int i = bid * 512 + tid; i < nz; i += G * 512) z[i] = (u32x4){0u, 0u, 0u, 0u};
            }
            {
                const int* pos = (const int*)INP(1);
                for (int i = bid * 512 + tid; i < M * 32; i += G * 512) {
                    const int m = i >> 5, k = i & 31;
                    const float ang = (float)pos[m] * ((const float*)__builtin_amdgcn_kernarg_segment_ptr())[68 + k];
                    double rev = (double)ang * 0.15915494309189535; rev -= rint(rev);
                    const float rr = (float)(rev * 6.283185307179586);
                    *(f32x2*)(CS + (size_t)i * 2) = (f32x2){__cosf(rr), __sinf(rr)};
                }
            }
            norm_init(INP(0), INP(2), XB, H, gw, NGW, lane);
            __syncthreads();
        } else if (type == 1 || type == 2 || type == 5 || type == 7) {
            const int njobs = type == 5 ? 3 : type == 7 ? 2 : 1;
            for (int k = 0; k < njobs; ++k) {
                pg8::Gemm g; pg8::EpiAny E; E.cs = CS; E.qscale = qscale;
                if (type == 1) { g = pg8::Gemm{H, (const bf16_t*)(ws + WS_WGU + (size_t)(ab * 2 + l) * 44 * MiB), M, 2 * FF, D, D, D}; E.kind = 0; E.O = ACT; E.ldc = FF; }
                else if (type == 2) {
                    E.kind = 1;
                    if (sub == 0) { g = pg8::Gemm{ACT, (const bf16_t*)(ws + WS_WD + (size_t)(ab * 2 + l) * 22 * MiB), M, D, FF, FF, FF}; E.O = Y; E.ldc = D; }
                    else if (sub == 1) { g = pg8::Gemm{H, (const bf16_t*)(ws + WS_WIN_E), M, P_LD, D, D, D}; E.O = Pb; E.ldc = P_LD; }
                    else if (sub == 2) { g = pg8::Gemm{H, (const bf16_t*)(ws + WS_WOUT_E), M, D, D, D, D}; E.O = Y; E.ldc = D; }
                    else { g = pg8::Gemm{H, (const bf16_t*)(ws + WS_WOUT_O), M, D, D, D, D}; E.O = Y; E.ldc = D; }
                } else if (type == 5) {
                    if (k == 0) { g = pg8::Gemm{Pb, (const bf16_t*)(ws + WS_WUQ), M, QW, 512, P_LD, 512}; E.kind = 3; E.O = Qb; E.ldc = QW; }
                    else if (k == 1) { g = pg8::Gemm{Pb + OFF_CKV, (const bf16_t*)(ws + WS_WUKV), M, 1024, 512, P_LD, 512}; E.kind = 1; E.O = KNb; E.ldc = 1024; }
                    else { g = pg8::Gemm{(const bf16_t*)(ws + WS_WUKV) + (size_t)1024 * 512, Pb + OFF_CKV, 1024, M, 512, 512, P_LD}; E.kind = 1; E.O = VTb; E.ldc = M; }
                } else {
                    E.kind = 2;
                    if (k == 0) { g = pg8::Gemm{H, (const bf16_t*)(ws + WS_WIN_O), M, D, D, D, D}; E.O = Ub; E.ldc = D; }
                    else { g = pg8::Gemm{(const bf16_t*)(ws + WS_WIN_O) + (size_t)2048 * D, H, D, M, D, D, D}; E.O = VTo; E.ldc = M; }
                }
                pg8::StaticOrder S; S.init(g.M, g.N, G, bid);
                pg8::gemm_phase<pg8::EpiAny>(lds, g, S, E, tid);
            }
        } else if (type == 3) {
            float scale = 0.5f; const float* post; const float* pre; float* fout = nullptr;
            if (sub == 0) { post = INP(3); pre = INP(12); }
            else if (sub == 1) { scale = 1.0f; post = INP(13); pre = INP(7); }
            else if (sub == 2) { post = INP(8); pre = INP(2) + D; }
            else if (sub == 3) { post = INP(3) + D; pre = INP(24); }
            else if (sub == 4) { scale = 1.0f; post = INP(25); pre = INP(7) + D; }
            else { post = INP(8) + D; pre = INP(2); fout = KARG_OUT; }
            norm_phase(XB, Y, scale, post, pre, H, fout, gw, NGW, lane);
        } else if (type == 4) {
            if (rep == 0) prep_phase(Pb, INP(15), INP(16), CS, gw, NGW, lane);
            conv_phase(lds, Pb, INP(19), INP(20), INP(21), INP(22), H, bid, G, tid);
        } else if (type == 6) {
            attn_phase(lds, Qb, KNb, Pb, VTb, H, bid, G, tid);
        } else {
            sgu_phase(lds, Ub, VTo, INP(27), INP(28), INP(29), INP(30), H, bid, G, tid);
        }
        if (rep + 1 < reps) ++rep; else { rep = 0; ++ph; }
        if (ph < ph_hi) { GRID_BAR();
#if BAR_TRIPLE
            GRID_BAR(); GRID_BAR();
#endif
        }
    }
}

extern "C" void kernel_launch(void* const* d_in, const int* in_sizes, int n_in, void* d_out, int out_size, void* d_ws, size_t ws_size, hipStream_t stream) {
    static int grid = 0;
    if (grid == 0) {
        if (n_in != 32 || in_sizes[0] != M * D || out_size != M * D || ws_size < WS_END) {
            fprintf(stderr, "kernel_launch: unexpected problem (n_in %d, in0 %d, out %d, ws %zu need %zu); nothing launched\n", n_in, n_in > 0 ? in_sizes[0] : -1, out_size, ws_size, (size_t)WS_END);
            grid = -1; return;
        }
        int dev = 0, cus = 0, per_cu = 0;
        (void)hipGetDevice(&dev);
        (void)hipDeviceGetAttribute(&cus, hipDeviceAttributeMultiprocessorCount, dev);
        if (hipFuncSetAttribute((const void*)mk_fwd, hipFuncAttributeMaxDynamicSharedMemorySize, LDS_BYTES) != hipSuccess) { fprintf(stderr, "kernel_launch: hipFuncSetAttribute failed\n"); grid = -1; return; }
        if (hipOccupancyMaxActiveBlocksPerMultiprocessor(&per_cu, (const void*)mk_fwd, 512, LDS_BYTES) != hipSuccess || per_cu < 1) { fprintf(stderr, "kernel_launch: occupancy query says %d\n", per_cu); per_cu = 1; }
        (void)hipGetLastError();
        if (cus <= 0) cus = 256;
        grid = cus * per_cu;
    }
    if (grid < 0) return;
    Params p{};
    for (int i = 0; i < 32; ++i) p.in[i] = (const float*)d_in[i];
    p.out = (float*)d_out; p.ws = (unsigned char*)d_ws;
    for (int i = 0; i < 32; ++i) p.inv_freq[i] = powf(10000.0f, -(float)(2 * i) / 64.0f);
#if MK_DEBUG_MULTI
    for (int ph = 0; ph < NPHASE; ++ph) {
        p.ph_lo = ph; p.ph_hi = ph + 1;
        hipLaunchKernelGGL(mk_fwd, dim3(grid), dim3(512), LDS_BYTES, stream, p);
    }
#else
    p.ph_lo = 0; p.ph_hi = NPHASE;
    void* args[] = {&p};
    hipError_t e = hipLaunchCooperativeKernel((const void*)mk_fwd, dim3(grid), dim3(512), args, LDS_BYTES, stream);
    if (e != hipSuccess) fprintf(stderr, "kernel_launch: cooperative launch failed: %s (grid %d)\n", hipGetErrorString(e), grid);
#endif
}
```

```cpp
#include <hip/hip_runtime.h>
#include <hip/hip_cooperative_groups.h>
#include <cstdio>
#include <cstdint>
#include <cmath>
#include <cstddef>
namespace cg = cooperative_groups;

#ifndef REPEAT_MASK
#define REPEAT_MASK 0
#endif
#ifndef BAR_TRIPLE
#define BAR_TRIPLE 0
#endif
#ifndef NORM_DUMMY
#define NORM_DUMMY 0
#endif
#ifndef MK_DEBUG_MULTI
#define MK_DEBUG_MULTI 0
#endif

#define LAS __attribute__((address_space(3)))
typedef unsigned short bf16_t;
typedef short bf16x8 __attribute__((ext_vector_type(8)));
typedef float f32x4 __attribute__((ext_vector_type(4)));
typedef float f32x2 __attribute__((ext_vector_type(2)));
typedef unsigned u32x4 __attribute__((ext_vector_type(4)));
typedef unsigned u32x2 __attribute__((ext_vector_type(2)));

constexpr int M = 32768, D = 2048, FF = 5632, SEQ = 2048, NBATCH = 16;
constexpr int P_LD = 3328;
constexpr int OFF_CKV = 512, OFF_KR = 1024, OFF_CONV = 1088, OFF_GATE = 2112, OFF_KPE = 3136;
constexpr int QW = 1536;
constexpr float EPS = 1e-6f;
constexpr int NPHASE = 23;

constexpr size_t MiB = 1u << 20;
constexpr size_t WS_WGU = 1 * MiB;
constexpr size_t WS_WD = 177 * MiB;
constexpr size_t WS_WIN_E = 265 * MiB;
constexpr size_t WS_WUQ = 278 * MiB;
constexpr size_t WS_WUKV = 280 * MiB;
constexpr size_t WS_WOUT_E = 282 * MiB;
constexpr size_t WS_WIN_O = 290 * MiB;
constexpr size_t WS_WOUT_O = 306 * MiB;
constexpr size_t WS_CS = 314 * MiB;
constexpr size_t WS_H = 322 * MiB;
constexpr size_t WS_Y = 450 * MiB;
constexpr size_t WS_ACT = 578 * MiB;
constexpr size_t WS_END = 930 * MiB;
constexpr int LDS_BYTES = 147456;

__device__ __forceinline__ unsigned cvt_pk_bf16(float lo, float hi) { unsigned r; asm("v_cvt_pk_bf16_f32 %0, %1, %2" : "=v"(r) : "v"(lo), "v"(hi)); return r; }
__device__ __forceinline__ float bf_lo(unsigned u) { return __uint_as_float(u << 16); }
__device__ __forceinline__ float bf_hi(unsigned u) { return __uint_as_float(u & 0xffff0000u); }
__device__ __forceinline__ float wave_sum(float v) {
#pragma unroll
    for (int o = 1; o < 64; o <<= 1) v += __shfl_xor(v, o);
    return v;
}
__device__ __forceinline__ float fast_sigmoid(float x) { return __builtin_amdgcn_rcpf(1.0f + __builtin_amdgcn_exp2f(-1.4426950408889634f * x)); }
__device__ __forceinline__ float silu_f(float x) { return x * fast_sigmoid(x); }
__device__ __forceinline__ float gelu_tanh_f(float x) {
    const float y = 1.5957691216057308f * (x + 0.044715f * x * x * x);
    return x * fast_sigmoid(y);
}
#define LDS_WAIT() asm volatile("s_waitcnt lgkmcnt(0)" ::: "memory")

namespace pg8 {
constexpr int BM = 256, BK = 64, HALF = 128, HTB = HALF * BK * 2, STAGE_BYTES = 8 * HTB, NXCD = 8, WGM = 8;
__device__ __forceinline__ int lds_byte(int r, int c) { const int st = (r >> 4) * 2 + (c >> 5), rr = r & 15, cc = c & 31, ob = rr * 64 + cc * 2; return st * 1024 + (ob ^ (((ob >> 9) & 1) << 5)); }
__device__ __forceinline__ void stage_rc(int b, int& R, int& C) { const int st = b / 1024, sb = b % 1024, swz = sb ^ (((sb >> 9) & 1) << 5); R = (st >> 1) * 16 + swz / 64; C = (st & 1) * 32 + (swz % 64) / 2; }
__device__ __forceinline__ int perm32(int rho) { const int n = rho >> 4, i = rho & 15; return 8 * (i >> 2) + 4 * n + (i & 3); }

struct Unit { int pm, pn; };
struct Gemm { const bf16_t* A; const bf16_t* Bt; int M, N, K, lda, ldb; };

struct StaticOrder {
    int nM, nN, nwg, G, c;
    __device__ void init(int M_, int N_, int G_, int c_) { nM = M_ / BM; nN = N_ / BM; nwg = nM * nN; G = G_; c = c_; }
    __device__ bool next(int i, Unit& u) const {
        const long L = (long)i * G + c; if (L >= nwg) return false;
        int wgid = (int)L; { const int q = nwg / NXCD, r = nwg % NXCD, xcd = wgid % NXCD, off = wgid / NXCD; wgid = (xcd < r ? xcd * (q + 1) : r * (q + 1) + (xcd - r) * q) + off; }
        const int nig = WGM * nN, gid = wgid / nig, fm = gid * WGM, gsz = (nM - fm) < WGM ? (nM - fm) : WGM;
        u.pm = fm + ((wgid % nig) % gsz); u.pn = (wgid % nig) / gsz; return true;
    }
};


struct EpiSwiGLU {
    bf16_t* O; int ldc;
    __device__ __forceinline__ void operator()(const f32x4 (&acc)[2][2][4][2], const Unit& u, int wr, int wc, int fr, int fq) const {
        const int row0 = u.pm * BM + wr * 64 + fr, col0 = u.pn * HALF + wc * 32 + 8 * fq;
#pragma unroll
        for (int ai = 0; ai < 2; ++ai)
#pragma unroll
            for (int m = 0; m < 4; ++m) {
                bf16_t* rowp = O + (size_t)(row0 + ai * HALF + m * 16) * ldc + col0;
                f32x4 v0, v1;
#pragma unroll
                for (int n = 0; n < 2; ++n)
#pragma unroll
                    for (int q = 0; q < 2; ++q) {
                        const f32x2 gg = {acc[ai][0][m][n][2 * q], acc[ai][0][m][n][2 * q + 1]}, uu = {acc[ai][1][m][n][2 * q], acc[ai][1][m][n][2 * q + 1]};
                        const f32x2 t = gg * (-1.4426950408889634f);
                        f32x2 e; e.x = __builtin_amdgcn_exp2f(t.x); e.y = __builtin_amdgcn_exp2f(t.y);
                        const f32x2 d = e + 1.0f;
                        f32x2 r; r.x = __builtin_amdgcn_rcpf(d.x); r.y = __builtin_amdgcn_rcpf(d.y);
                        const f32x2 o = (gg * uu) * r;
                        if (n == 0) { v0[2 * q] = o.x; v0[2 * q + 1] = o.y; } else { v1[2 * q] = o.x; v1[2 * q + 1] = o.y; }
                    }
                u32x4 w; w.x = cvt_pk_bf16(v0[0], v0[1]); w.y = cvt_pk_bf16(v0[2], v0[3]); w.z = cvt_pk_bf16(v1[0], v1[1]); w.w = cvt_pk_bf16(v1[2], v1[3]);
                *(u32x4*)rowp = w;
            }
    }
};
template <int ACT  > struct EpiBf16 {
    bf16_t* O; int ldc;
    __device__ __forceinline__ void operator()(const f32x4 (&acc)[2][2][4][2], const Unit& u, int wr, int wc, int fr, int fq) const {
        const int row0 = u.pm * BM + wr * 64 + fr, col0 = u.pn * BM + wc * 32 + 8 * fq;
#pragma unroll
        for (int ai = 0; ai < 2; ++ai)
#pragma unroll
            for (int m = 0; m < 4; ++m) {
                bf16_t* rowp = O + (size_t)(row0 + ai * HALF + m * 16) * ldc + col0;
#pragma unroll
                for (int bj = 0; bj < 2; ++bj) {
                    f32x4 v0 = acc[ai][bj][m][0], v1 = acc[ai][bj][m][1];
                    if (ACT == 1) {
#pragma unroll
                        for (int j = 0; j < 4; ++j) { v0[j] = gelu_tanh_f(v0[j]); v1[j] = gelu_tanh_f(v1[j]); }
                    }
                    u32x4 w; w.x = cvt_pk_bf16(v0[0], v0[1]); w.y = cvt_pk_bf16(v0[2], v0[3]); w.z = cvt_pk_bf16(v1[0], v1[1]); w.w = cvt_pk_bf16(v1[2], v1[3]);
                    *(u32x4*)(rowp + bj * HALF) = w;
                }
            }
    }
};
struct EpiQRope {
    bf16_t* O; const float* cs; float qscale;
    __device__ __forceinline__ void operator()(const f32x4 (&acc)[2][2][4][2], const Unit& u, int wr, int wc, int fr, int fq) const {
        const int row0 = u.pm * BM + wr * 64 + fr, col0 = u.pn * BM + wc * 32 + 8 * fq;
#pragma unroll
        for (int ai = 0; ai < 2; ++ai)
#pragma unroll
            for (int m = 0; m < 4; ++m) {
                const int row = row0 + ai * HALF + m * 16;
                bf16_t* rowp = O + (size_t)row * QW + col0;
#pragma unroll
                for (int bj = 0; bj < 2; ++bj) {
                    f32x4 v0 = acc[ai][bj][m][0], v1 = acc[ai][bj][m][1];
                    const int cc = (col0 + bj * HALF) % 192;
                    if (cc >= 128) {
                        const int i0 = (cc - 128) >> 1;
                        const f32x4 c01 = *(const f32x4*)(cs + (size_t)row * 64 + i0 * 2), c23 = *(const f32x4*)(cs + (size_t)row * 64 + i0 * 2 + 4);
                        f32x4 r0, r1;
                        r0[0] = v0[0] * c01[0] - v0[1] * c01[1]; r0[1] = v0[1] * c01[0] + v0[0] * c01[1];
                        r0[2] = v0[2] * c01[2] - v0[3] * c01[3]; r0[3] = v0[3] * c01[2] + v0[2] * c01[3];
                        r1[0] = v1[0] * c23[0] - v1[1] * c23[1]; r1[1] = v1[1] * c23[0] + v1[0] * c23[1];
                        r1[2] = v1[2] * c23[2] - v1[3] * c23[3]; r1[3] = v1[3] * c23[2] + v1[2] * c23[3];
                        v0 = r0; v1 = r1;
                    }
                    v0 = v0 * qscale; v1 = v1 * qscale;
                    u32x4 w; w.x = cvt_pk_bf16(v0[0], v0[1]); w.y = cvt_pk_bf16(v0[2], v0[3]); w.z = cvt_pk_bf16(v1[0], v1[1]); w.w = cvt_pk_bf16(v1[2], v1[3]);
                    *(u32x4*)(rowp + bj * HALF) = w;
                }
                asm volatile("" ::: "memory");
            }
    }
};

struct EpiAny {
    int kind;
    bf16_t* O; int ldc; const float* cs; float qscale;
    __device__ __forceinline__ void operator()(const f32x4 (&acc)[2][2][4][2], const Unit& u, int wr, int wc, int fr, int fq) const {
        if (kind == 0) { EpiSwiGLU e{O, ldc}; e(acc, u, wr, wc, fr, fq); }
        else if (kind == 1) { EpiBf16<0> e{O, ldc}; e(acc, u, wr, wc, fr, fq); }
        else if (kind == 2) { EpiBf16<1> e{O, ldc}; e(acc, u, wr, wc, fr, fq); }
        else { EpiQRope e{O, cs, qscale}; e(acc, u, wr, wc, fr, fq); }
    }
};

template <class Epi>
__device__ __forceinline__ void gemm_phase(LAS unsigned char* lds, const Gemm g, const StaticOrder& S, const Epi& E, const int tid) {
    const int wid = __builtin_amdgcn_readfirstlane(tid >> 6), lane = tid & 63, wr = wid >> 2, wc = wid & 3, fr = lane & 15, fq = lane >> 4;
    const int K = g.K, nt = K / BK;
    unsigned voffA[2], voffB[2];
#pragma unroll
    for (int i = 0; i < 2; ++i) { int R, C; stage_rc(tid * 16 + i * 8192, R, C); const int Rb = (R & ~31) + perm32(R & 31);
        voffA[i] = (unsigned)(R * g.lda + C) * 2u; voffB[i] = (unsigned)(Rb * g.ldb + C) * 2u; }
    const size_t kstep = (size_t)(BK * 2);
    const size_t hstepA = (size_t)HALF * g.lda * 2, hstepB = (size_t)HALF * g.ldb * 2;
    const size_t tstepA = 2 * hstepA, tstepB = 2 * hstepB;
    const unsigned ldsw = (unsigned)wid * 1024u;
    const int aoff = lds_byte(wr * 64 + fr, fq * 8), boff = lds_byte(wc * 32 + fr, fq * 8);
#define PG8_SA(b, h) (((b) * 2 + (h)) * HTB)
#define PG8_SB(b, h) ((4 + (b) * 2 + (h)) * HTB)
#define PG8_STAGE(bufoff, gbase, voff) do { _Pragma("unroll") for (int _i = 0; _i < 2; ++_i) \
        __builtin_amdgcn_global_load_lds((const unsigned*)((const char*)(gbase) + (voff)[_i]), (LAS unsigned*)(lds + (bufoff) + ldsw + _i * 8192), 16, 0, 0); } while (0)
#define PG8_LDA(dst, b, h) do { _Pragma("unroll") for (int m = 0; m < 4; ++m) _Pragma("unroll") for (int k = 0; k < 2; ++k) dst[m][k] = *(const LAS bf16x8*)(lds + PG8_SA(b, h) + aoff + m * 2048 + k * 1024); } while (0)
#define PG8_LDB(dst, b, h) do { _Pragma("unroll") for (int n = 0; n < 2; ++n) _Pragma("unroll") for (int k = 0; k < 2; ++k) dst[n][k] = *(const LAS bf16x8*)(lds + PG8_SB(b, h) + boff + n * 2048 + k * 1024); } while (0)
#define PG8_MMA(ai, bj, At, Bt) do { __builtin_amdgcn_s_setprio(1); _Pragma("unroll") for (int m = 0; m < 4; ++m) _Pragma("unroll") for (int n = 0; n < 2; ++n) _Pragma("unroll") for (int k = 0; k < 2; ++k) \
        acc[ai][bj][m][n] = __builtin_amdgcn_mfma_f32_16x16x32_bf16(Bt[n][k], At[m][k], acc[ai][bj][m][n], 0, 0, 0); __builtin_amdgcn_s_setprio(0); } while (0)
#define PG8_WAIT_V(n) asm volatile("s_waitcnt vmcnt(" #n ")" ::: "memory")
#define PG8_WAIT_L(n) asm volatile("s_waitcnt lgkmcnt(" #n ")" ::: "memory")
#define PG8_BAR __builtin_amdgcn_s_barrier()
#define PG8_SCHED __builtin_amdgcn_sched_barrier(0)
    Unit cur, nxt; int ui = 0;
    if (!S.next(0, cur)) return;
    f32x4 acc[2][2][4][2];
#pragma unroll
    for (int a = 0; a < 2; ++a)
#pragma unroll
        for (int b = 0; b < 2; ++b)
#pragma unroll
            for (int m = 0; m < 4; ++m)
#pragma unroll
                for (int n = 0; n < 2; ++n) acc[a][b][m][n] = (f32x4){0.f, 0.f, 0.f, 0.f};
    bf16x8 At[4][2], B0[2][2], B1[2][2];
    const char* cA = (const char*)g.A + (size_t)cur.pm * tstepA; const char* cB = (const char*)g.Bt + (size_t)cur.pn * tstepB;
    PG8_STAGE(PG8_SB(0, 0), cB, voffB); PG8_STAGE(PG8_SB(0, 1), cB + hstepB, voffB); PG8_STAGE(PG8_SA(0, 0), cA, voffA); PG8_STAGE(PG8_SA(0, 1), cA + hstepA, voffA);
    if (wr == 1) PG8_BAR;
    PG8_WAIT_V(2); PG8_BAR;
    PG8_STAGE(PG8_SB(1, 0), cB + kstep, voffB); PG8_STAGE(PG8_SA(1, 0), cA + kstep, voffA); PG8_STAGE(PG8_SB(1, 1), cB + hstepB + kstep, voffB);
    PG8_WAIT_V(6); PG8_BAR;
    for (;;) {
        const bool has_next = S.next(ui + 1, nxt);
        const char* nA = has_next ? (const char*)g.A + (size_t)nxt.pm * tstepA : cA; const char* nB = has_next ? (const char*)g.Bt + (size_t)nxt.pn * tstepB : cB;
        for (int t = 0; t < nt; t += 2) {
            const bool last = (t == nt - 2);
            const char* a1 = cA + (size_t)(t + 1) * kstep;
            const char* a2 = last ? nA : cA + (size_t)(t + 2) * kstep; const char* b2 = last ? nB : cB + (size_t)(t + 2) * kstep;
            const char* a3 = a2 + kstep; const char* b3 = b2 + kstep;
            PG8_LDB(B0, 0, 0); PG8_LDB(B1, 0, 1); PG8_SCHED; PG8_LDA(At, 0, 0); PG8_STAGE(PG8_SA(1, 1), a1 + hstepA, voffA);
            PG8_WAIT_V(8); PG8_WAIT_L(0); PG8_BAR; PG8_MMA(0, 0, At, B0); PG8_MMA(0, 1, At, B1); PG8_BAR; PG8_SCHED;
            PG8_LDA(At, 0, 1); PG8_STAGE(PG8_SB(0, 0), b2, voffB); PG8_STAGE(PG8_SB(0, 1), b2 + hstepB, voffB); PG8_STAGE(PG8_SA(0, 0), a2, voffA);
            PG8_WAIT_V(8); PG8_WAIT_L(0); PG8_BAR; PG8_MMA(1, 0, At, B0); PG8_MMA(1, 1, At, B1); PG8_BAR; PG8_SCHED;
            PG8_LDB(B0, 1, 0); PG8_LDB(B1, 1, 1); PG8_SCHED; PG8_LDA(At, 1, 0); PG8_STAGE(PG8_SA(0, 1), a2 + hstepA, voffA);
            PG8_WAIT_V(8); PG8_WAIT_L(0); PG8_BAR; PG8_MMA(0, 0, At, B0); PG8_MMA(0, 1, At, B1); PG8_BAR; PG8_SCHED;
            PG8_LDA(At, 1, 1); PG8_STAGE(PG8_SB(1, 0), b3, voffB); PG8_STAGE(PG8_SB(1, 1), b3 + hstepB, voffB); PG8_STAGE(PG8_SA(1, 0), a3, voffA);
            PG8_WAIT_V(8); PG8_WAIT_L(0); PG8_BAR; PG8_MMA(1, 0, At, B0); PG8_MMA(1, 1, At, B1); PG8_BAR; PG8_SCHED;
        }
        if (wr == 0) PG8_BAR;
        E(acc, cur, wr, wc, fr, fq);
        if (!has_next) break;
#pragma unroll
        for (int a = 0; a < 2; ++a)
#pragma unroll
            for (int b = 0; b < 2; ++b)
#pragma unroll
                for (int m = 0; m < 4; ++m)
#pragma unroll
                    for (int n = 0; n < 2; ++n) acc[a][b][m][n] = (f32x4){0.f, 0.f, 0.f, 0.f};
        cur = nxt; cA = nA; cB = nB; ++ui;
        if (wr == 1) PG8_BAR;
    }
    PG8_WAIT_V(0);
    PG8_BAR;
#undef PG8_SA
#undef PG8_SB
#undef PG8_STAGE
#undef PG8_LDA
#undef PG8_LDB
#undef PG8_MMA
#undef PG8_WAIT_V
#undef PG8_WAIT_L
#undef PG8_BAR
#undef PG8_SCHED
}
}

enum { MAP_PLAIN = 0, MAP_GU = 1, MAP_UQ = 2, MAP_UKV = 3 };
__device__ __forceinline__ int map_row(int mode, int n, int sel) {
    if (mode == MAP_GU) return (n >> 7) * 256 + (n & 127) + sel * 128;
    if (mode == MAP_UQ) { const int h = n / 192, c = n - h * 192; if (c < 128) return n; const int r = c - 128; return h * 192 + 128 + 2 * (r & 31) + (r >> 5); }
    if (mode == MAP_UKV) { const int h = n >> 8, c = n & 255; return (c < 128 ? 0 : 1024) + h * 128 + (c & 127); }
    return n;
}
__device__ __forceinline__ void transpose_item(const float* W, int K, int N, bf16_t* WT, int mode, int sel, LAS float* scr, int item, int lane) {
    const int nblk = N / 32, kb = item / nblk, nb = item - kb * nblk, k0 = 64 * kb, n0 = 32 * nb;
    const int l7 = lane & 7, l3 = lane >> 3;
#pragma unroll
    for (int i = 0; i < 8; ++i) {
        const int kk = l3 + 8 * i;
        const f32x4 v = *(const f32x4*)(W + (size_t)(k0 + kk) * N + n0 + l7 * 4);
        LAS float* s = scr + kk * 33 + l7 * 4;
        s[0] = v[0]; s[1] = v[1]; s[2] = v[2]; s[3] = v[3];
    }
    LDS_WAIT(); asm volatile("" ::: "memory");
#pragma unroll
    for (int j = 0; j < 4; ++j) {
        const int n = l3 + 8 * j; const LAS float* s = scr + (8 * l7) * 33 + n;
        u32x4 o; o.x = cvt_pk_bf16(s[0 * 33], s[1 * 33]); o.y = cvt_pk_bf16(s[2 * 33], s[3 * 33]); o.z = cvt_pk_bf16(s[4 * 33], s[5 * 33]); o.w = cvt_pk_bf16(s[6 * 33], s[7 * 33]);
        *(u32x4*)(WT + (size_t)map_row(mode, n0 + n, sel) * K + k0 + 8 * l7) = o;
    }
    LDS_WAIT(); asm volatile("" ::: "memory");
}

__device__ __forceinline__ void norm_init(const float* xin, const float* pre_g, bf16_t* XB, bf16_t* h, int gw, int NGW, int lane) {
    f32x4 xn[8];
    int m = gw;
    if (m < M) {
#pragma unroll
        for (int j = 0; j < 8; ++j) xn[j] = *(const f32x4*)(xin + (size_t)m * D + lane * 4 + 256 * j);
    }
    for (; m < M; m += NGW) {
        f32x4 xv[8]; float ss = 0.f;
#pragma unroll
        for (int j = 0; j < 8; ++j) { xv[j] = xn[j]; ss += (xv[j][0] * xv[j][0] + xv[j][1] * xv[j][1]) + (xv[j][2] * xv[j][2] + xv[j][3] * xv[j][3]); }
        const int m2 = m + NGW;
        if (m2 < M) {
#pragma unroll
            for (int j = 0; j < 8; ++j) xn[j] = *(const f32x4*)(xin + (size_t)m2 * D + lane * 4 + 256 * j);
        }
        const float rs = __builtin_amdgcn_rsqf(wave_sum(ss) * (1.0f / D) + EPS);
        bf16_t* xo = XB + (size_t)m * D + lane * 4; bf16_t* hr = h + (size_t)m * D + lane * 4;
#pragma unroll
        for (int j = 0; j < 8; ++j) { const f32x4 g = *(const f32x4*)(pre_g + lane * 4 + 256 * j); const f32x4 o = xv[j] * g * rs;
            u32x2 w; w.x = cvt_pk_bf16(xv[j][0], xv[j][1]); w.y = cvt_pk_bf16(xv[j][2], xv[j][3]); *(u32x2*)(xo + 256 * j) = w;
            u32x2 v; v.x = cvt_pk_bf16(o[0], o[1]); v.y = cvt_pk_bf16(o[2], o[3]); *(u32x2*)(hr + 256 * j) = v; }
    }
}
__device__ __forceinline__ void norm_phase(bf16_t* XB, const bf16_t* y, float scale, const float* post_g, const float* pre_g, bf16_t* h, float* fout, int gw, int NGW, int lane) {
    f32x4 gp[8], gq[8];
#pragma unroll
    for (int j = 0; j < 8; ++j) { gp[j] = *(const f32x4*)(post_g + lane * 4 + 256 * j); gq[j] = *(const f32x4*)(pre_g + lane * 4 + 256 * j); }
    u32x2 xn[8], yn[8];
    int m = gw;
    if (m < M) {
#pragma unroll
        for (int j = 0; j < 8; ++j) { xn[j] = *(const u32x2*)(XB + (size_t)m * D + lane * 4 + 256 * j); yn[j] = *(const u32x2*)(y + (size_t)m * D + lane * 4 + 256 * j); }
    }
    for (; m < M; m += NGW) {
        f32x4 xv[8], yv[8]; float ss = 0.f;
#pragma unroll
        for (int j = 0; j < 8; ++j) { xv[j] = (f32x4){bf_lo(xn[j].x), bf_hi(xn[j].x), bf_lo(xn[j].y), bf_hi(xn[j].y)}; yv[j] = (f32x4){bf_lo(yn[j].x), bf_hi(yn[j].x), bf_lo(yn[j].y), bf_hi(yn[j].y)};
            ss += (yv[j][0] * yv[j][0] + yv[j][1] * yv[j][1]) + (yv[j][2] * yv[j][2] + yv[j][3] * yv[j][3]); }
        const int m2 = m + NGW;
        if (m2 < M) {
#pragma unroll
            for (int j = 0; j < 8; ++j) { xn[j] = *(const u32x2*)(XB + (size_t)m2 * D + lane * 4 + 256 * j); yn[j] = *(const u32x2*)(y + (size_t)m2 * D + lane * 4 + 256 * j); }
        }
        const float rs = scale * __builtin_amdgcn_rsqf(wave_sum(ss) * (1.0f / D) + EPS);
        float s2 = 0.f;
#pragma unroll
        for (int j = 0; j < 8; ++j) { xv[j] = xv[j] + yv[j] * gp[j] * rs; s2 += (xv[j][0] * xv[j][0] + xv[j][1] * xv[j][1]) + (xv[j][2] * xv[j][2] + xv[j][3] * xv[j][3]); }
        if (fout) {
            float* fo = fout + (size_t)m * D + lane * 4;
#pragma unroll
            for (int j = 0; j < 8; ++j) *(f32x4*)(fo + 256 * j) = xv[j];
        } else {
            const float r2 = __builtin_amdgcn_rsqf(wave_sum(s2) * (1.0f / D) + EPS);
            bf16_t* xo = XB + (size_t)m * D + lane * 4; bf16_t* hr = h + (size_t)m * D + lane * 4;
#pragma unroll
            for (int j = 0; j < 8; ++j) { const f32x4 o = xv[j] * gq[j] * r2;
                u32x2 w; w.x = cvt_pk_bf16(xv[j][0], xv[j][1]); w.y = cvt_pk_bf16(xv[j][2], xv[j][3]); *(u32x2*)(xo + 256 * j) = w;
                u32x2 v; v.x = cvt_pk_bf16(o[0], o[1]); v.y = cvt_pk_bf16(o[2], o[3]); *(u32x2*)(hr + 256 * j) = v; }
        }
    }
}

__device__ __forceinline__ void prep_phase(bf16_t* P, const float* qg, const float* kvg, const float* cs, int gw, int NGW, int lane) {
    for (int m = gw; m < M; m += NGW) {
        bf16_t* pr = P + (size_t)m * P_LD;
#pragma unroll
        for (int part = 0; part < 2; ++part) {
            bf16_t* q = pr + part * 512 + lane * 8;
            const float* g = (part ? kvg : qg) + lane * 8;
            const u32x4 t = *(const u32x4*)q;
            float v[8] = {bf_lo(t.x), bf_hi(t.x), bf_lo(t.y), bf_hi(t.y), bf_lo(t.z), bf_hi(t.z), bf_lo(t.w), bf_hi(t.w)};
            float ss = 0.f;
#pragma unroll
            for (int e = 0; e < 8; ++e) ss += v[e] * v[e];
            const float rs = __builtin_amdgcn_rsqf(wave_sum(ss) * (1.0f / 512.0f) + EPS);
            const f32x4 g0 = *(const f32x4*)g, g1 = *(const f32x4*)(g + 4);
            u32x4 o; o.x = cvt_pk_bf16(v[0] * rs * g0[0], v[1] * rs * g0[1]); o.y = cvt_pk_bf16(v[2] * rs * g0[2], v[3] * rs * g0[3]);
            o.z = cvt_pk_bf16(v[4] * rs * g1[0], v[5] * rs * g1[1]); o.w = cvt_pk_bf16(v[6] * rs * g1[2], v[7] * rs * g1[3]);
            *(u32x4*)q = o;
        }
        if (lane < 32) {
            const float x1 = bf_lo((unsigned)pr[OFF_KR + lane]), x2 = bf_lo((unsigned)pr[OFF_KR + 32 + lane]);
            const f32x2 c = *(const f32x2*)(cs + (size_t)m * 64 + lane * 2);
            *(unsigned*)(pr + OFF_KPE + 2 * lane) = cvt_pk_bf16(x1 * c[0] - x2 * c[1], x2 * c[0] + x1 * c[1]);
        }
    }
}

__device__ __forceinline__ void conv_phase(LAS unsigned char* lds, const bf16_t* P, const float* cw, const float* cb, const float* ng, const float* nb, bf16_t* CAT, int bid, int G, const int tid) {
    LAS float* zs = (LAS float*)lds;
    LAS float* co = (LAS float*)(lds + 94 * 128 * 4);
    const int lane = tid & 63, w = tid >> 6;
    u32x4 ra[3], rg[3];
#define CONV_LOAD(uu) do { const int g_ = (uu) & 7, tt_ = ((uu) >> 3) & 31, b_ = (uu) >> 8; \
        _Pragma("unroll") for (int i = 0; i < 3; ++i) { const int ch = tid + 512 * i, r = ch >> 4, c8 = ch & 15, t = tt_ * 64 - 30 + r; \
            ra[i] = (u32x4){0u, 0u, 0u, 0u}; rg[i] = (u32x4){0u, 0u, 0u, 0u}; \
            if (ch < 94 * 16 && t >= 0) { const bf16_t* src = P + (size_t)(b_ * SEQ + t) * P_LD + g_ * 128 + c8 * 8; ra[i] = *(const u32x4*)(src + OFF_CONV); rg[i] = *(const u32x4*)(src + OFF_GATE); } } } while (0)
    if (bid < 4096) CONV_LOAD(bid);
    for (int u = bid; u < 4096; u += G) {
        const int g = u & 7, tt = (u >> 3) & 31, b = u >> 8, t0 = tt * 64;
#pragma unroll
        for (int i = 0; i < 3; ++i) {
            const int ch = tid + 512 * i, r = ch >> 4, c8 = ch & 15;
            if (ch < 94 * 16) {
                const u32x4 a = ra[i], gt = rg[i];
                f32x4 z0, z1;
                z0[0] = bf_lo(a.x) * fast_sigmoid(bf_lo(gt.x)); z0[1] = bf_hi(a.x) * fast_sigmoid(bf_hi(gt.x));
                z0[2] = bf_lo(a.y) * fast_sigmoid(bf_lo(gt.y)); z0[3] = bf_hi(a.y) * fast_sigmoid(bf_hi(gt.y));
                z1[0] = bf_lo(a.z) * fast_sigmoid(bf_lo(gt.z)); z1[1] = bf_hi(a.z) * fast_sigmoid(bf_hi(gt.z));
                z1[2] = bf_lo(a.w) * fast_sigmoid(bf_lo(gt.w)); z1[3] = bf_hi(a.w) * fast_sigmoid(bf_hi(gt.w));
                *(LAS f32x4*)(zs + r * 128 + c8 * 8) = z0; *(LAS f32x4*)(zs + r * 128 + c8 * 8 + 4) = z1;
            }
        }
        __syncthreads();
        if (u + G < 4096) CONV_LOAD(u + G);
        {
            const int c = tid & 127, tb = tid >> 7;
            float wj[31];
#pragma unroll
            for (int j = 0; j < 31; ++j) wj[j] = cw[j * 1024 + g * 128 + c];
            const float bias = cb[g * 128 + c];
            float acc[16];
#pragma unroll
            for (int o = 0; o < 16; ++o) acc[o] = bias;
#pragma unroll
            for (int i = 0; i < 46; ++i) {
                const float z = zs[(tb * 16 + i) * 128 + c];
#pragma unroll
                for (int o = 0; o < 16; ++o) { const int j = i - o; if (j >= 0 && j <= 30) acc[o] += wj[j] * z; }
            }
#pragma unroll
            for (int o = 0; o < 16; ++o) co[(tb * 16 + o) * 128 + c] = acc[o];
        }
        __syncthreads();
        {
            const f32x2 gg = *(const f32x2*)(ng + g * 128 + 2 * lane), bb = *(const f32x2*)(nb + g * 128 + 2 * lane);
#pragma unroll
            for (int k = 0; k < 8; ++k) {
                const int tok = w * 8 + k;
                const f32x2 v = *(const LAS f32x2*)(co + tok * 128 + 2 * lane);
                const float mean = wave_sum(v[0] + v[1]) * (1.0f / 128.0f);
                const float d0 = v[0] - mean, d1 = v[1] - mean;
                const float rs = __builtin_amdgcn_rsqf(wave_sum(d0 * d0 + d1 * d1) * (1.0f / 128.0f) + EPS);
                const float y0 = d0 * rs * gg[0] + bb[0], y1 = d1 * rs * gg[1] + bb[1];
                *(unsigned*)(CAT + (size_t)(b * SEQ + t0 + tok) * D + 1024 + g * 128 + 2 * lane) = cvt_pk_bf16(silu_f(y0), silu_f(y1));
            }
        }
    }
#undef CONV_LOAD
    __syncthreads();
}

__device__ __forceinline__ void attn_phase(LAS unsigned char* lds, const bf16_t* Q, const bf16_t* KN, const bf16_t* P, const bf16_t* VT, bf16_t* CAT, int bid, int G, const int tid) {
    constexpr int KS = 200, VS = 72, KBYTES = 64 * KS * 2, VBYTES = 128 * VS * 2, BUFB = KBYTES + VBYTES;
    const int lane = tid & 63, w = __builtin_amdgcn_readfirstlane(tid >> 6), fr = lane & 15, fq = lane >> 4;
    for (int u = bid; u < 1024; u += G) {
        const int rnd = u >> 8, c = u & 255, bh = c >> 1, half = c & 1;
        const int qb = half ? (rnd == 0 ? 5 : rnd == 1 ? 2 : rnd == 2 ? 4 : 3) : (rnd == 0 ? 7 : rnd == 1 ? 0 : rnd == 2 ? 6 : 1);
        const int b = bh >> 3, hh = bh & 7, nt = 4 * (qb + 1);
        const size_t tok0 = (size_t)b * SEQ;
        const int qlo = qb * 256 + 32 * w;
        bf16x8 qf[2][6];
#pragma unroll
        for (int qi = 0; qi < 2; ++qi)
#pragma unroll
            for (int ch = 0; ch < 6; ++ch) qf[qi][ch] = *(const bf16x8*)(Q + (tok0 + qlo + 16 * qi + fr) * QW + hh * 192 + ch * 32 + fq * 8);
        f32x4 o[8][2];
#pragma unroll
        for (int d = 0; d < 8; ++d) { o[d][0] = (f32x4){0.f, 0.f, 0.f, 0.f}; o[d][1] = (f32x4){0.f, 0.f, 0.f, 0.f}; }
        float mrow[2] = {-INFINITY, -INFINITY}, lrow[2] = {0.f, 0.f};
        const int kkey0 = tid >> 4, kc16 = tid & 15;
        const int pkey = tid >> 3, pc8 = tid & 7;
        const int vd0 = tid >> 3, vc8 = tid & 7;
        const bf16_t* gk = KN + (tok0 + kkey0) * 1024 + hh * 128 + kc16 * 8;
        const bf16_t* gp = P + (tok0 + pkey) * P_LD + OFF_KPE + pc8 * 8;
        const bf16_t* gv = VT + (size_t)(hh * 128 + vd0) * M + tok0 + vc8 * 8;
        const int lk = (kkey0 * KS + kc16 * 8) * 2, lp = (pkey * KS + 128 + pc8 * 8) * 2, lv = KBYTES + (vd0 * VS + vc8 * 8) * 2;
        u32x4 rk0, rk1, rp, rv0, rv1;
        rk0 = *(const u32x4*)(gk); rk1 = *(const u32x4*)(gk + 32 * 1024); rp = *(const u32x4*)(gp);
        rv0 = *(const u32x4*)(gv); rv1 = *(const u32x4*)(gv + (size_t)64 * M);
        for (int kt = 0; kt < nt; ++kt) {
            LAS unsigned char* buf = lds + (kt & 1) * BUFB;
            *(LAS u32x4*)(buf + lk) = rk0; *(LAS u32x4*)(buf + lk + 32 * KS * 2) = rk1; *(LAS u32x4*)(buf + lp) = rp;
            *(LAS u32x4*)(buf + lv) = rv0; *(LAS u32x4*)(buf + lv + 64 * VS * 2) = rv1;
            __syncthreads();
            if (kt + 1 < nt) {
                const size_t ko = (size_t)(kt + 1) * 64;
                rk0 = *(const u32x4*)(gk + ko * 1024); rk1 = *(const u32x4*)(gk + (ko + 32) * 1024); rp = *(const u32x4*)(gp + ko * P_LD);
                rv0 = *(const u32x4*)(gv + ko); rv1 = *(const u32x4*)(gv + (size_t)64 * M + ko);
            }
            if (kt * 64 <= qlo + 31) {
                f32x4 s[4][2];
#pragma unroll
                for (int kb = 0; kb < 4; ++kb) { s[kb][0] = (f32x4){0.f, 0.f, 0.f, 0.f}; s[kb][1] = (f32x4){0.f, 0.f, 0.f, 0.f}; }
#pragma unroll
                for (int ch = 0; ch < 6; ++ch) {
#pragma unroll
                    for (int kb = 0; kb < 4; ++kb) {
                        const bf16x8 kf = *(const LAS bf16x8*)(buf + ((kb * 16 + fr) * KS + ch * 32 + fq * 8) * 2);
                        s[kb][0] = __builtin_amdgcn_mfma_f32_16x16x32_bf16(kf, qf[0][ch], s[kb][0], 0, 0, 0);
                        s[kb][1] = __builtin_amdgcn_mfma_f32_16x16x32_bf16(kf, qf[1][ch], s[kb][1], 0, 0, 0);
                    }
                    if (ch & 1) asm volatile("" ::: "memory");
                }
                if (kt * 64 + 63 > qlo) {
#pragma unroll
                    for (int kb = 0; kb < 4; ++kb)
#pragma unroll
                        for (int qi = 0; qi < 2; ++qi)
#pragma unroll
                            for (int j = 0; j < 4; ++j) { const int key = kt * 64 + kb * 16 + fq * 4 + j, q = qlo + qi * 16 + fr; if (key > q) s[kb][qi][j] = -INFINITY; }
                }
                bf16x8 pf[2][2];
#pragma unroll
                for (int qi = 0; qi < 2; ++qi) {
                    float mx = -INFINITY;
#pragma unroll
                    for (int kb = 0; kb < 4; ++kb) mx = fmaxf(mx, fmaxf(fmaxf(s[kb][qi][0], s[kb][qi][1]), fmaxf(s[kb][qi][2], s[kb][qi][3])));
                    mx = fmaxf(mx, __shfl_xor(mx, 16)); mx = fmaxf(mx, __shfl_xor(mx, 32));
                    const float mnew = fmaxf(mrow[qi], mx);
                    const float alpha = __builtin_amdgcn_exp2f(mrow[qi] - mnew);
                    mrow[qi] = mnew;
                    float ps = 0.f;
#pragma unroll
                    for (int kb = 0; kb < 4; ++kb)
#pragma unroll
                        for (int j = 0; j < 4; ++j) { const float e = __builtin_amdgcn_exp2f(s[kb][qi][j] - mnew); s[kb][qi][j] = e; ps += e; }
                    lrow[qi] = lrow[qi] * alpha + ps;
#pragma unroll
                    for (int d = 0; d < 8; ++d) o[d][qi] = o[d][qi] * alpha;
#pragma unroll
                    for (int cc = 0; cc < 2; ++cc) {
                        u32x4 t; t.x = cvt_pk_bf16(s[2 * cc][qi][0], s[2 * cc][qi][1]); t.y = cvt_pk_bf16(s[2 * cc][qi][2], s[2 * cc][qi][3]);
                        t.z = cvt_pk_bf16(s[2 * cc + 1][qi][0], s[2 * cc + 1][qi][1]); t.w = cvt_pk_bf16(s[2 * cc + 1][qi][2], s[2 * cc + 1][qi][3]);
                        pf[qi][cc] = __builtin_bit_cast(bf16x8, t);
                    }
                }
#pragma unroll
                for (int cc = 0; cc < 2; ++cc)
#pragma unroll
                    for (int d = 0; d < 8; ++d) {
                        const LAS unsigned char* vp = buf + KBYTES + ((d * 16 + fr) * VS + 32 * cc + 4 * fq) * 2;
                        const u32x2 v0 = *(const LAS u32x2*)vp, v1 = *(const LAS u32x2*)(vp + 32);
                        const u32x4 vv = {v0.x, v0.y, v1.x, v1.y};
                        const bf16x8 vf = __builtin_bit_cast(bf16x8, vv);
                        o[d][0] = __builtin_amdgcn_mfma_f32_16x16x32_bf16(vf, pf[0][cc], o[d][0], 0, 0, 0);
                        o[d][1] = __builtin_amdgcn_mfma_f32_16x16x32_bf16(vf, pf[1][cc], o[d][1], 0, 0, 0);
                    }
            }
        }
#pragma unroll
        for (int qi = 0; qi < 2; ++qi) {
            float l = lrow[qi]; l += __shfl_xor(l, 16); l += __shfl_xor(l, 32);
            const float inv = 1.0f / l;
            bf16_t* op = CAT + (tok0 + qlo + 16 * qi + fr) * D + hh * 128 + fq * 4;
#pragma unroll
            for (int d = 0; d < 8; ++d) { const f32x4 v = o[d][qi] * inv; u32x2 t; t.x = cvt_pk_bf16(v[0], v[1]); t.y = cvt_pk_bf16(v[2], v[3]); *(u32x2*)(op + d * 16) = t; }
        }
    }
    __syncthreads();
}

__device__ __forceinline__ void sgu_phase(LAS unsigned char* lds, const bf16_t* U, const bf16_t* VTg, const float* vg, const float* vb, const float* wsp, const float* bsp, bf16_t* Gout, int bid, int G, const int tid) {
    constexpr int RS = 136;
    LAS bf16_t* Ws = (LAS bf16_t*)lds;
    LAS bf16_t* Vs = (LAS bf16_t*)(lds + 128 * RS * 2);
    LAS float* red = (LAS float*)(lds + 128 * RS * 2);
    LAS float* st = (LAS float*)(lds + 128 * RS * 2 + 256 * RS * 2);
    const int lane = tid & 63, w = __builtin_amdgcn_readfirstlane(tid >> 6), fr = lane & 15, fq = lane >> 4;
    for (int ci = bid; ci < 256; ci += G) {
        const size_t r0 = (size_t)ci * 128;
        {
            const int rg = tid >> 4, tc = tid & 15;
            float s1[8], s2[8];
#pragma unroll
            for (int e = 0; e < 8; ++e) { s1[e] = 0.f; s2[e] = 0.f; }
#pragma unroll 8
            for (int pass = 0; pass < 64; ++pass) {
                const u32x4 t = *(const u32x4*)((const char*)(VTg + (size_t)(pass * 32) * M + r0) + (unsigned)((rg * M + tc * 8) * 2));
                const float v[8] = {bf_lo(t.x), bf_hi(t.x), bf_lo(t.y), bf_hi(t.y), bf_lo(t.z), bf_hi(t.z), bf_lo(t.w), bf_hi(t.w)};
#pragma unroll
                for (int e = 0; e < 8; ++e) { s1[e] += v[e]; s2[e] += v[e] * v[e]; }
            }
#pragma unroll
            for (int e = 0; e < 8; ++e) *(LAS f32x2*)(red + (rg * 128 + tc * 8 + e) * 2) = (f32x2){s1[e], s2[e]};
        }
        __syncthreads();
        if (tid < 128) {
            float a = 0.f, q = 0.f;
#pragma unroll 8
            for (int rg = 0; rg < 32; ++rg) { const f32x2 t = *(const LAS f32x2*)(red + (rg * 128 + tid) * 2); a += t[0]; q += t[1]; }
            const float mean = a * (1.0f / 2048.0f), var = fmaxf(q * (1.0f / 2048.0f) - mean * mean, 0.f);
            *(LAS f32x2*)(st + tid * 2) = (f32x2){mean, __builtin_amdgcn_rsqf(var + EPS)};
        }
        __syncthreads();
        f32x4 wreg[8]; u32x4 vreg[8]; float gar[8], ber[8];
        const unsigned voffW = (unsigned)(((tid >> 5) * 128 + (tid & 31) * 4) * 4), voffV = (unsigned)(((tid >> 4) * M + (tid & 15) * 8) * 2), voffG = (unsigned)((tid >> 4) * 4);
#define SGU_LOAD(gg) do { _Pragma("unroll") for (int i = 0; i < 8; ++i) { \
            const char* bw = (const char*)(wsp + (size_t)(gg) * 16384 + i * 2048); wreg[i] = *(const f32x4*)(bw + voffW); \
            const char* bv = (const char*)(VTg + (size_t)((gg) * 256 + 32 * i) * M + r0); vreg[i] = *(const u32x4*)(bv + voffV); \
            gar[i] = *(const float*)((const char*)(vg + (gg) * 256 + 32 * i) + voffG); ber[i] = *(const float*)((const char*)(vb + (gg) * 256 + 32 * i) + voffG); } } while (0)
        SGU_LOAD(0);
        for (int g = 0; g < 8; ++g) {
#pragma unroll
            for (int i = 0; i < 8; ++i) {
                const int idx = tid + 512 * i, t = idx >> 5, s4 = (idx & 31) * 4;
                f32x4 v = wreg[i];
#pragma unroll
                for (int e = 0; e < 4; ++e) if (s4 + e > t) v[e] = 0.f;
                u32x2 o; o.x = cvt_pk_bf16(v[0], v[1]); o.y = cvt_pk_bf16(v[2], v[3]);
                *(LAS u32x2*)(Ws + t * RS + s4) = o;
            }
#pragma unroll
            for (int i = 0; i < 8; ++i) {
                const int idx = tid + 512 * i, d = idx >> 4, tc = idx & 15;
                const u32x4 t = vreg[i];
                const float ga = gar[i], be = ber[i];
                float v[8] = {bf_lo(t.x), bf_hi(t.x), bf_lo(t.y), bf_hi(t.y), bf_lo(t.z), bf_hi(t.z), bf_lo(t.w), bf_hi(t.w)};
#pragma unroll
                for (int e = 0; e < 8; ++e) { const f32x2 ms = *(const LAS f32x2*)(st + (tc * 8 + e) * 2); v[e] = (v[e] - ms[0]) * ms[1] * ga + be; }
                u32x4 o; o.x = cvt_pk_bf16(v[0], v[1]); o.y = cvt_pk_bf16(v[2], v[3]); o.z = cvt_pk_bf16(v[4], v[5]); o.w = cvt_pk_bf16(v[6], v[7]);
                *(LAS u32x4*)(Vs + d * RS + tc * 8) = o;
            }
            __syncthreads();
            if (g + 1 < 8) SGU_LOAD(g + 1);
#pragma unroll 1
            for (int hf = 0; hf < 2; ++hf) {
                u32x2 ureg[8];
                const int t = 16 * w + fr;
                const unsigned voffU = (unsigned)((t * D + fq * 4) * 2);
                const char* bu = (const char*)(U + r0 * D + g * 256 + hf * 128); char* bg = (char*)(Gout + r0 * D + g * 256 + hf * 128);
#pragma unroll
                for (int d = 0; d < 8; ++d) ureg[d] = *(const u32x2*)(bu + voffU + d * 32);
                f32x4 acc[8];
#pragma unroll
                for (int d = 0; d < 8; ++d) acc[d] = (f32x4){0.f, 0.f, 0.f, 0.f};
                const int nsc = (w >> 1) + 1;
                for (int sc = 0; sc < nsc; ++sc) {
                    const bf16x8 wf = *(const LAS bf16x8*)(Ws + (16 * w + fr) * RS + sc * 32 + fq * 8);
#pragma unroll
                    for (int d = 0; d < 8; ++d) {
                        const bf16x8 vf = *(const LAS bf16x8*)(Vs + ((hf * 8 + d) * 16 + fr) * RS + sc * 32 + fq * 8);
                        acc[d] = __builtin_amdgcn_mfma_f32_16x16x32_bf16(vf, wf, acc[d], 0, 0, 0);
                    }
                }
                const float bias = bsp[g * 128 + t];
#pragma unroll
                for (int d = 0; d < 8; ++d) {
                    const u32x2 uu = ureg[d];
                    u32x2 o; o.x = cvt_pk_bf16(bf_lo(uu.x) * (acc[d][0] + bias), bf_hi(uu.x) * (acc[d][1] + bias));
                    o.y = cvt_pk_bf16(bf_lo(uu.y) * (acc[d][2] + bias), bf_hi(uu.y) * (acc[d][3] + bias));
                    *(u32x2*)(bg + voffU + d * 32) = o;
                }
            }
            __syncthreads();
        }
#undef SGU_LOAD
    }
}

#define XB_TMO      128
#define XB_XCNT(j)  (256  + 64 * (j))
#define XB_XSUB(j)  (1280 + 64 * (j))
#define XB_XGEN(j)  (2304 + 64 * (j))
#define XB_TOP      3328
#define XB_TOPGEN   3392
#define XCD_BAR_WORDS 3456
#define XB_SPIN_CAP (1u << 22)
__device__ __forceinline__ unsigned xb_ld(unsigned* p)              { return __hip_atomic_load(p, __ATOMIC_RELAXED, __HIP_MEMORY_SCOPE_AGENT); }
__device__ __forceinline__ unsigned xb_add(unsigned* p, unsigned v) { return __hip_atomic_fetch_add(p, v, __ATOMIC_RELAXED, __HIP_MEMORY_SCOPE_AGENT); }
__device__ __forceinline__ unsigned xb_xcc_id() { return (unsigned)__builtin_amdgcn_s_getreg((3 << 11) | 20) & 0xFu; }
#define XB_SPIN(cond, bar) do { unsigned _sp = 0; while (cond) { __builtin_amdgcn_s_sleep(1); \
    if ((++_sp & 255u) == 0u) { if (xb_ld(&(bar)[XB_TMO])) break; if (_sp > XB_SPIN_CAP) { atomicAdd(&(bar)[XB_TMO], 1u); break; } } } } while (0)
struct XcdBarrier { unsigned* bar; unsigned x; volatile LAS unsigned* st; };
__device__ __forceinline__ XcdBarrier xcd_barrier_post(unsigned* bar, volatile LAS unsigned* st) {
    XcdBarrier b; b.bar = bar; b.x = xb_xcc_id(); b.st = st;
    if (threadIdx.x == 0) (void)xb_add(&bar[XB_XCNT(b.x)], 1u);
    return b;
}
__device__ __forceinline__ void xcd_barrier_complete(unsigned* bar, unsigned x, unsigned& nloc, unsigned& nx) {
    const unsigned G = gridDim.x * gridDim.y * gridDim.z;
    unsigned sum, cnt, mine, sp = 0u;
    for (;;) {
        sum = 0u; cnt = 0u; mine = 0u;
#pragma unroll
        for (unsigned j = 0; j < 16; ++j) { const unsigned c = xb_ld(&bar[XB_XCNT(j)]); sum += c; cnt += (c > 0u) ? 1u : 0u; mine = (j == x) ? c : mine; }
        if (sum == G) break;
        __builtin_amdgcn_s_sleep(1);
        if ((++sp & 255u) == 0u) { if (xb_ld(&bar[XB_TMO])) break; if (sp > XB_SPIN_CAP) { atomicAdd(&bar[XB_TMO], 1u); break; } }
    }
    nloc = mine > 0u ? mine : 1u; nx = cnt > 0u ? cnt : 1u;
}
__device__ __forceinline__ void xcd_barrier(const XcdBarrier& b) {
    asm volatile("s_waitcnt vmcnt(0)" ::: "memory");
    __syncthreads();
    if (threadIdx.x == 0) {
        unsigned* bar = b.bar;
        __builtin_amdgcn_s_waitcnt(0);
        unsigned nloc = b.st[0], nx = b.st[1];
        if (nloc == 0u) { xcd_barrier_complete(bar, b.x, nloc, nx); b.st[0] = nloc; b.st[1] = nx; }
        const unsigned old = xb_add(&bar[XB_XSUB(b.x)], 1u);
        const unsigned gen = old / nloc;
        if (old + 1u == (gen + 1u) * nloc) {
            __builtin_amdgcn_fence(__ATOMIC_RELEASE, "agent");
            asm volatile("s_waitcnt vmcnt(0)" ::: "memory");
            const unsigned og = xb_add(&bar[XB_TOP], 1u);
            const unsigned tg = og / nx;
            if (og + 1u == (tg + 1u) * nx) xb_add(&bar[XB_TOPGEN], 1u);
            else XB_SPIN(xb_ld(&bar[XB_TOPGEN]) == tg, bar);
            __builtin_amdgcn_fence(__ATOMIC_ACQUIRE, "agent");
            xb_add(&bar[XB_XGEN(b.x)], 1u);
            asm volatile("s_waitcnt vmcnt(0)" ::: "memory");
        } else {
            XB_SPIN(xb_ld(&bar[XB_XGEN(b.x)]) == gen, bar);
            __builtin_amdgcn_fence(__ATOMIC_ACQUIRE, "agent");
            asm volatile("s_waitcnt vmcnt(0)" ::: "memory");
        }
    }
    __syncthreads();
}

template <int OFF> __device__ __forceinline__ const void* karg_ptr() {
    const unsigned long long base = (unsigned long long)__builtin_amdgcn_kernarg_segment_ptr();
    unsigned long long r;
    asm volatile("s_load_dwordx2 %0, %1, %2\n\ts_waitcnt lgkmcnt(0)" : "=s"(r) : "s"(base), "n"(OFF) : "memory");
    return (const void*)r;
}
__device__ __forceinline__ const void* karg_ptr_dyn(int off) {
    const unsigned long long base = (unsigned long long)__builtin_amdgcn_kernarg_segment_ptr();
    unsigned long long r; const int o = __builtin_amdgcn_readfirstlane(off);
    asm volatile("s_load_dwordx2 %0, %1, %2\n\ts_waitcnt lgkmcnt(0)" : "=s"(r) : "s"(base), "s"(o) : "memory");
    return (const void*)r;
}
template <int OFF> __device__ __forceinline__ int karg_int() {
    const unsigned long long base = (unsigned long long)__builtin_amdgcn_kernarg_segment_ptr();
    int r;
    asm volatile("s_load_dword %0, %1, %2\n\ts_waitcnt lgkmcnt(0)" : "=s"(r) : "s"(base), "n"(OFF) : "memory");
    return r;
}
#define INP(k) ((const float*)karg_ptr<8 * (k)>())
#define KARG_OUT ((float*)karg_ptr<256>())
#define KARG_WS ((unsigned char*)karg_ptr<264>())

struct Params {
    const float* in[32];
    float* out; unsigned char* ws;
    float inv_freq[32];
    int ph_lo, ph_hi;
};

static_assert(offsetof(Params, out) == 256 && offsetof(Params, ws) == 264 && offsetof(Params, inv_freq) == 272 && offsetof(Params, ph_lo) == 400 && offsetof(Params, ph_hi) == 404 && sizeof(Params) == 408, "kernarg layout");
__global__ void __launch_bounds__(512, 2) mk_fwd(Params p) {
    extern __shared__ __attribute__((aligned(16))) unsigned char lds_raw[];
    LAS unsigned char* lds = (LAS unsigned char*)lds_raw;
    cg::grid_group grid = cg::this_grid();
    const float qscale = 0.07216878364870322f * 1.4426950408889634f;

    const int ph_lo = karg_int<400>(), ph_hi = karg_int<404>();
    volatile LAS unsigned* bst = (volatile LAS unsigned*)(lds + 131072 + 1024);
    if (threadIdx.x < 4) bst[threadIdx.x] = 0u;
    __syncthreads();
    XcdBarrier xbar; xbar.bar = (unsigned*)KARG_WS; xbar.x = 0; xbar.st = bst;
    if (ph_hi - ph_lo > 1) {
        xbar = xcd_barrier_post((unsigned*)KARG_WS, bst);
        grid.sync();
    }
    int rep = 0;
    for (int ph = ph_lo; ph < ph_hi;) {
        int tid = threadIdx.x, bid = blockIdx.x, G = gridDim.x;
        asm volatile("" : "+v"(tid)); asm volatile("" : "+s"(bid)); asm volatile("" : "+s"(G));
        const int lane = tid & 63, wave = __builtin_amdgcn_readfirstlane(tid >> 6);
        const int gw = bid * 8 + wave, NGW = G * 8;
        unsigned char* ws = KARG_WS;
        bf16_t* const XB = (bf16_t*)(ws + WS_H);
        bf16_t* const H = (bf16_t*)KARG_OUT;
        bf16_t* const Y = (bf16_t*)(ws + WS_Y);
        bf16_t* const ACT = (bf16_t*)(ws + WS_ACT);
        bf16_t* const Pb = ACT;
        bf16_t* const Qb = ACT + (size_t)M * P_LD;
        bf16_t* const KNb = Y;
        bf16_t* const VTb = Y + (size_t)M * 1024;
        bf16_t* const Ub = ACT;
        bf16_t* const VTo = ACT + (size_t)M * 2048;
        float* const CS = (float*)(ws + WS_CS);
        int type = 0, ab = 0, l = 0, sub = 0;
        switch (ph) {
            case 0: type = 0; break;
            case 1: type = 1; ab = 0; l = 0; break;
            case 2: type = 2; sub = 0; ab = 0; l = 0; break;
            case 3: type = 3; sub = 0; break;
            case 4: type = 2; sub = 1; break;
            case 5: type = 4; break;
            case 6: type = 5; break;
            case 7: type = 6; break;
            case 8: type = 2; sub = 2; break;
            case 9: type = 3; sub = 1; break;
            case 10: type = 1; ab = 1; l = 0; break;
            case 11: type = 2; sub = 0; ab = 1; l = 0; break;
            case 12: type = 3; sub = 2; break;
            case 13: type = 1; ab = 0; l = 1; break;
            case 14: type = 2; sub = 0; ab = 0; l = 1; break;
            case 15: type = 3; sub = 3; break;
            case 16: type = 7; break;
            case 17: type = 8; break;
            case 18: type = 2; sub = 3; break;
            case 19: type = 3; sub = 4; break;
            case 20: type = 1; ab = 1; l = 1; break;
            case 21: type = 2; sub = 0; ab = 1; l = 1; break;
            default: type = 3; sub = 5; break;
        }
        const int reps = ((REPEAT_MASK >> type) & 1) ? 2 : 1;
        if (type == 0) {
            LAS float* scr = (LAS float*)(lds + wave * 16384);
            constexpr int I_FFN = 5632, I_WIN_E = 32 * 98, I_UQ = 8 * 48, I_UKV = 8 * 64, I_SQ = 32 * 64, I_WIN_O = 32 * 128;
            constexpr int NITEMS = 12 * I_FFN + I_WIN_E + I_UQ + I_UKV + I_SQ + I_WIN_O + I_SQ;
            for (int it = gw; it < NITEMS; it += NGW) {
                int r = it;
                if (r < 12 * I_FFN) {
                    const int mi = r / I_FFN; r -= mi * I_FFN;
                    const int fab = mi / 6, rem = mi - fab * 6, fl = rem / 3, kind = rem - fl * 3;
                    const float* src = (const float*)karg_ptr_dyn(8 * (4 + fab * 5 + kind));
                    src += (size_t)fl * D * FF;
                    if (kind < 2) transpose_item(src, D, FF, (bf16_t*)(ws + WS_WGU + (size_t)(fab * 2 + fl) * 44 * MiB), MAP_GU, kind, scr, r, lane);
                    else transpose_item(src, FF, D, (bf16_t*)(ws + WS_WD + (size_t)(fab * 2 + fl) * 22 * MiB), MAP_PLAIN, 0, scr, r, lane);
                    continue;
                }
                r -= 12 * I_FFN;
                if (r < I_WIN_E) { transpose_item(INP(14), D, 3136, (bf16_t*)(ws + WS_WIN_E), MAP_PLAIN, 0, scr, r, lane); continue; } r -= I_WIN_E;
                if (r < I_UQ) { transpose_item(INP(17), 512, QW, (bf16_t*)(ws + WS_WUQ), MAP_UQ, 0, scr, r, lane); continue; } r -= I_UQ;
                if (r < I_UKV) { transpose_item(INP(18), 512, 2048, (bf16_t*)(ws + WS_WUKV), MAP_UKV, 0, scr, r, lane); continue; } r -= I_UKV;
                if (r < I_SQ) { transpose_item(INP(23), D, D, (bf16_t*)(ws + WS_WOUT_E), MAP_PLAIN, 0, scr, r, lane); continue; } r -= I_SQ;
                if (r < I_WIN_O) { transpose_item(INP(26), D, 4096, (bf16_t*)(ws + WS_WIN_O), MAP_PLAIN, 0, scr, r, lane); continue; } r -= I_WIN_O;
                transpose_item(INP(31), D, D, (bf16_t*)(ws + WS_WOUT_O), MAP_PLAIN, 0, scr, r, lane);
            }
            {
                u32x4* z = (u32x4*)(ws + WS_WIN_E + (size_t)3136 * D * 2);
                const int nz = 192 * D * 2 / 16;
                for (int i = bid * 512 + tid; i < nz; i += G * 512) z[i] = (u32x4){0u, 0u, 0u, 0u};
            }
            {
                const int* pos = (const int*)INP(1);
                for (int i = bid * 512 + tid; i < M * 32; i += G * 512) {
                    const int m = i >> 5, k = i & 31;
                    const float ang = (float)pos[m] * ((const float*)__builtin_amdgcn_kernarg_segment_ptr())[68 + k];
                    double rev = (double)ang * 0.15915494309189535; rev -= rint(rev);
                    const float rr = (float)(rev * 6.283185307179586);
                    *(f32x2*)(CS + (size_t)i * 2) = (f32x2){__cosf(rr), __sinf(rr)};
                }
            }
            norm_init(INP(0), INP(2), XB, H, gw, NGW, lane);
            __syncthreads();
        } else if (type == 1 || type == 2 || type == 5 || type == 7) {
            const int njobs = type == 5 ? 3 : type == 7 ? 2 : 1;
            for (int k = 0; k < njobs; ++k) {
                pg8::Gemm g; pg8::EpiAny E; E.cs = CS; E.qscale = qscale;
                if (type == 1) { g = pg8::Gemm{H, (const bf16_t*)(ws + WS_WGU + (size_t)(ab * 2 + l) * 44 * MiB), M, 2 * FF, D, D, D}; E.kind = 0; E.O = ACT; E.ldc = FF; }
                else if (type == 2) {
                    E.kind = 1;
                    if (sub == 0) { g = pg8::Gemm{ACT, (const bf16_t*)(ws + WS_WD + (size_t)(ab * 2 + l) * 22 * MiB), M, D, FF, FF, FF}; E.O = Y; E.ldc = D; }
                    else if (sub == 1) { g = pg8::Gemm{H, (const bf16_t*)(ws + WS_WIN_E), M, P_LD, D, D, D}; E.O = Pb; E.ldc = P_LD; }
                    else if (sub == 2) { g = pg8::Gemm{H, (const bf16_t*)(ws + WS_WOUT_E), M, D, D, D, D}; E.O = Y; E.ldc = D; }
                    else { g = pg8::Gemm{H, (const bf16_t*)(ws + WS_WOUT_O), M, D, D, D, D}; E.O = Y; E.ldc = D; }
                } else if (type == 5) {
                    if (k == 0) { g = pg8::Gemm{Pb, (const bf16_t*)(ws + WS_WUQ), M, QW, 512, P_LD, 512}; E.kind = 3; E.O = Qb; E.ldc = QW; }
                    else if (k == 1) { g = pg8::Gemm{Pb + OFF_CKV, (const bf16_t*)(ws + WS_WUKV), M, 1024, 512, P_LD, 512}; E.kind = 1; E.O = KNb; E.ldc = 1024; }
                    else { g = pg8::Gemm{(const bf16_t*)(ws + WS_WUKV) + (size_t)1024 * 512, Pb + OFF_CKV, 1024, M, 512, 512, P_LD}; E.kind = 1; E.O = VTb; E.ldc = M; }
                } else {
                    E.kind = 2;
                    if (k == 0) { g = pg8::Gemm{H, (const bf16_t*)(ws + WS_WIN_O), M, D, D, D, D}; E.O = Ub; E.ldc = D; }
                    else { g = pg8::Gemm{(const bf16_t*)(ws + WS_WIN_O) + (size_t)2048 * D, H, D, M, D, D, D}; E.O = VTo; E.ldc = M; }
                }
                pg8::StaticOrder S; S.init(g.M, g.N, G, bid);
                pg8::gemm_phase<pg8::EpiAny>(lds, g, S, E, tid);
            }
        } else if (type == 3) {
            float scale = 0.5f; const float* post; const float* pre; float* fout = nullptr;
            if (sub == 0) { post = INP(3); pre = INP(12); }
            else if (sub == 1) { scale = 1.0f; post = INP(13); pre = INP(7); }
            else if (sub == 2) { post = INP(8); pre = INP(2) + D; }
            else if (sub == 3) { post = INP(3) + D; pre = INP(24); }
            else if (sub == 4) { scale = 1.0f; post = INP(25); pre = INP(7) + D; }
            else { post = INP(8) + D; pre = INP(2); fout = KARG_OUT; }
            norm_phase(XB, Y, scale, post, pre, H, fout, gw, NGW, lane);
        } else if (type == 4) {
            if (rep == 0) prep_phase(Pb, INP(15), INP(16), CS, gw, NGW, lane);
            conv_phase(lds, Pb, INP(19), INP(20), INP(21), INP(22), H, bid, G, tid);
        } else if (type == 6) {
            attn_phase(lds, Qb, KNb, Pb, VTb, H, bid, G, tid);
        } else {
            sgu_phase(lds, Ub, VTo, INP(27), INP(28), INP(29), INP(30), H, bid, G, tid);
        }
        if (rep + 1 < reps) ++rep; else { rep = 0; ++ph; }
        if (ph < ph_hi) { xcd_barrier(xbar);
#if BAR_TRIPLE
            xcd_barrier(xbar); xcd_barrier(xbar);
#endif
        }
    }
}

extern "C" void kernel_launch(void* const* d_in, const int* in_sizes, int n_in, void* d_out, int out_size, void* d_ws, size_t ws_size, hipStream_t stream) {
    static int grid = 0;
    if (grid == 0) {
        if (n_in != 32 || in_sizes[0] != M * D || out_size != M * D || ws_size < WS_END) {
            fprintf(stderr, "kernel_launch: unexpected problem (n_in %d, in0 %d, out %d, ws %zu need %zu); nothing launched\n", n_in, n_in > 0 ? in_sizes[0] : -1, out_size, ws_size, (size_t)WS_END);
            grid = -1; return;
        }
        int dev = 0, cus = 0, per_cu = 0;
        (void)hipGetDevice(&dev);
        (void)hipDeviceGetAttribute(&cus, hipDeviceAttributeMultiprocessorCount, dev);
        if (hipFuncSetAttribute((const void*)mk_fwd, hipFuncAttributeMaxDynamicSharedMemorySize, LDS_BYTES) != hipSuccess) { fprintf(stderr, "kernel_launch: hipFuncSetAttribute failed\n"); grid = -1; return; }
        if (hipOccupancyMaxActiveBlocksPerMultiprocessor(&per_cu, (const void*)mk_fwd, 512, LDS_BYTES) != hipSuccess || per_cu < 1) { fprintf(stderr, "kernel_launch: occupancy query says %d\n", per_cu); per_cu = 1; }
        (void)hipGetLastError();
        if (cus <= 0) cus = 256;
        grid = cus * per_cu;
    }
    if (grid < 0) return;
    if (hipMemsetAsync(d_ws, 0, 65536, stream) != hipSuccess) { fprintf(stderr, "kernel_launch: memset failed\n"); return; }
    Params p{};
    for (int i = 0; i < 32; ++i) p.in[i] = (const float*)d_in[i];
    p.out = (float*)d_out; p.ws = (unsigned char*)d_ws;
    for (int i = 0; i < 32; ++i) p.inv_freq[i] = powf(10000.0f, -(float)(2 * i) / 64.0f);
#if MK_DEBUG_MULTI
    for (int ph = 0; ph < NPHASE; ++ph) {
        p.ph_lo = ph; p.ph_hi = ph + 1;
        hipLaunchKernelGGL(mk_fwd, dim3(grid), dim3(512), LDS_BYTES, stream, p);
    }
#else
    p.ph_lo = 0; p.ph_hi = NPHASE;
    void* args[] = {&p};
    hipError_t e = hipLaunchCooperativeKernel((const void*)mk_fwd, dim3(grid), dim3(512), args, LDS_BYTES, stream);
    if (e != hipSuccess) fprintf(stderr, "kernel_launch: cooperative launch failed: %s (grid %d)\n", hipGetErrorString(e), grid);
#endif
}
```
